# Optimizing an MI355X kernel written in HIP

```python
import math
import jax, jax.numpy as jnp
from jax import lax
import numpy as np

D_MODEL = 1024
BATCH = 8
SEQ = 4096
DEPTH = 1

EPS = 1e-6
CHUNK = 128
GM_GROUPS = 8
GM_GROUP_DIM = 64
GM_WIDTH = GM_GROUPS * GM_GROUP_DIM
WINDOW = 128
Q_HEADS = 8
KV_HEADS = 2
Q_PER_KV = Q_HEADS // KV_HEADS
HEAD_DIM = 64
ATTN_WIDTH = Q_HEADS * HEAD_DIM
KV_WIDTH = KV_HEADS * HEAD_DIM
REL_BUCKETS = 32
REL_MAX_EXACT = REL_BUCKETS // 2
REL_MAX_DIST = 128
N_GROUPS_MOE = 4
EXPERTS_PER_GROUP = 4
N_EXPERTS = N_GROUPS_MOE * EXPERTS_PER_GROUP
TOP_K = 2
EXPERT_FF = 512
MASK_VALUE = -1e30

SPLIT_SIZES = (GM_WIDTH, GM_WIDTH, ATTN_WIDTH, KV_WIDTH, KV_WIDTH, D_MODEL, D_MODEL)
SPLIT_POINTS = tuple(int(v) for v in np.cumsum(SPLIT_SIZES)[:-1])
IN_WIDTH = int(sum(SPLIT_SIZES))

kernel_name = "hybrid_gmlp_swa_sink_hiermoe_block"


def rms_norm(x, g):
    xf = x.astype(jnp.float32)
    y = xf * lax.rsqrt(jnp.mean(xf * xf, axis=-1, keepdims=True) + EPS)
    return (y * g.astype(jnp.float32)).astype(x.dtype)


def layer_norm(x, g):
    xf = x.astype(jnp.float32)
    mu = jnp.mean(xf, axis=-1, keepdims=True)
    xc = xf - mu
    y = xc * lax.rsqrt(jnp.mean(xc * xc, axis=-1, keepdims=True) + EPS)
    return (y * g.astype(jnp.float32)).astype(x.dtype)


def t5_causal_bucket(dist):
    is_small = dist < REL_MAX_EXACT
    nf = jnp.maximum(dist, 1).astype(jnp.float32)
    large = REL_MAX_EXACT + (
        jnp.log(nf / REL_MAX_EXACT) / math.log(REL_MAX_DIST / REL_MAX_EXACT)
        * (REL_BUCKETS - REL_MAX_EXACT)).astype(jnp.int32)
    large = jnp.minimum(large, REL_BUCKETS - 1)
    return jnp.where(is_small, dist, large)


def gmlp_chunk_mixer(u_raw, v_raw, v_norm_g, w_s, b_s):
    B, S, _ = u_raw.shape
    u = jax.nn.gelu(u_raw)
    v = layer_norm(jax.nn.gelu(v_raw), v_norm_g)
    v = v.reshape(B, S // CHUNK, CHUNK, GM_GROUPS, GM_GROUP_DIM)
    causal = jnp.tril(jnp.ones((CHUNK, CHUNK), dtype=bool))
    ws = jnp.where(causal[None], w_s, jnp.zeros((), w_s.dtype)).astype(v.dtype)
    sv = jnp.einsum("gts,bcsgd->bctgd", ws, v)
    sv = sv + b_s.T.astype(v.dtype)[None, None, :, :, None]
    return u * sv.reshape(B, S, GM_WIDTH)


def swa_sink_attention(q, k, v, sinks, rel_bias):
    B, S, _ = q.shape
    nb = S // WINDOW
    q = q.reshape(B, nb, WINDOW, KV_HEADS, Q_PER_KV, HEAD_DIM)
    k = k.reshape(B, nb, WINDOW, KV_HEADS, HEAD_DIM)
    v = v.reshape(B, nb, WINDOW, KV_HEADS, HEAD_DIM)
    k_prev = jnp.concatenate([jnp.zeros_like(k[:, :1]), k[:, :-1]], axis=1)
    v_prev = jnp.concatenate([jnp.zeros_like(v[:, :1]), v[:, :-1]], axis=1)
    kb = jnp.concatenate([k_prev, k], axis=2)
    vb = jnp.concatenate([v_prev, v], axis=2)

    scores = jnp.einsum("bnqkgd,bnskd->bnkgqs", q, kb,
                        preferred_element_type=jnp.float32) * (HEAD_DIM ** -0.5)

    qi = jnp.arange(WINDOW, dtype=jnp.int32)[:, None]
    sj = jnp.arange(2 * WINDOW, dtype=jnp.int32)[None, :]
    dist = qi + WINDOW - sj
    in_window = (dist >= 0) & (dist < WINDOW)
    bucket = t5_causal_bucket(jnp.clip(dist, 0, WINDOW - 1))
    bias = rel_bias.astype(jnp.float32)[bucket]
    bias = bias.transpose(2, 0, 1).reshape(KV_HEADS, Q_PER_KV, WINDOW, 2 * WINDOW)
    blk = jnp.arange(nb, dtype=jnp.int32)[:, None, None]
    valid = in_window[None] & ((blk > 0) | (sj[None] >= WINDOW))

    scores = scores + bias[None, None]
    scores = jnp.where(valid[None, :, None, None], scores, MASK_VALUE)
    sink = sinks.astype(jnp.float32).reshape(KV_HEADS, Q_PER_KV)[None, None, :, :, None, None]
    m = jnp.maximum(jnp.max(scores, axis=-1, keepdims=True), sink)
    p = jnp.exp(scores - m)
    denom = jnp.sum(p, axis=-1, keepdims=True) + jnp.exp(sink - m)
    probs = (p / denom).astype(vb.dtype)
    out = jnp.einsum("bnkgqs,bnskd->bnqkgd", probs, vb)
    return out.reshape(B, S, ATTN_WIDTH)


def hierarchical_moe(h, rg_w, rg_b, re_w, re_b, w_gate, w_up, w_down):
    B, S, D = h.shape
    t = h.reshape(-1, D)
    g_logits = jnp.dot(t, rg_w, preferred_element_type=jnp.float32) + rg_b.astype(jnp.float32)
    g_probs = jax.nn.softmax(g_logits, axis=-1)
    g_top_p, g_top_i = lax.top_k(g_probs, 1)
    e_all = jnp.einsum("td,gde->tge", t, re_w,
                       preferred_element_type=jnp.float32) + re_b.astype(jnp.float32)
    e_logits = jnp.take_along_axis(e_all, g_top_i[:, :, None], axis=1)[:, 0]
    e_top_v, e_top_i = lax.top_k(e_logits, TOP_K)
    w_top = jax.nn.softmax(e_top_v, axis=-1) * g_top_p
    expert_id = g_top_i * EXPERTS_PER_GROUP + e_top_i
    combine = jnp.einsum("tk,tke->te", w_top,
                         jax.nn.one_hot(expert_id, N_EXPERTS, dtype=jnp.float32))
    combine = combine.astype(t.dtype)
    out = jnp.zeros_like(t)
    for e in range(N_EXPERTS):
        hid = jax.nn.silu(t @ w_gate[e]) * (t @ w_up[e])
        out = out + combine[:, e:e + 1] * (hid @ w_down[e])
    return out.reshape(B, S, D)


def setup_inputs(seed: int = 0) -> dict:
    key = jax.random.key(seed)
    ks = jax.random.split(key, 20)
    f32 = jnp.float32
    nrm = lambda k, shape, scale: jax.random.normal(k, shape, f32) * scale
    L = DEPTH
    return {
        "x": jax.random.normal(ks[0], (BATCH, SEQ, D_MODEL), f32),
        "attn_norm_g": 1.0 + nrm(ks[1], (L, D_MODEL), 0.02),
        "w_in": nrm(ks[2], (L, D_MODEL, IN_WIDTH), D_MODEL ** -0.5),
        "gm_v_norm_g": 1.0 + nrm(ks[3], (L, GM_WIDTH), 0.02),
        "gm_w_spatial": nrm(ks[4], (L, GM_GROUPS, CHUNK, CHUNK), CHUNK ** -0.5),
        "gm_b_spatial": 1.0 + nrm(ks[5], (L, GM_GROUPS, CHUNK), 0.02),
        "attn_sinks": nrm(ks[6], (L, Q_HEADS), 0.5),
        "rel_bias": nrm(ks[7], (REL_BUCKETS, Q_HEADS), 0.5),
        "w_proj_a": nrm(ks[8], (L, GM_WIDTH, D_MODEL), GM_WIDTH ** -0.5),
        "w_proj_b": nrm(ks[9], (L, ATTN_WIDTH, D_MODEL), ATTN_WIDTH ** -0.5),
        "w_out": nrm(ks[10], (L, D_MODEL, D_MODEL), D_MODEL ** -0.5),
        "ffn_norm_g": 1.0 + nrm(ks[11], (L, D_MODEL), 0.02),
        "router_group_w": nrm(ks[12], (L, D_MODEL, N_GROUPS_MOE), D_MODEL ** -0.5),
        "router_group_b": nrm(ks[13], (L, N_GROUPS_MOE), 0.01),
        "router_expert_w": nrm(ks[14], (L, N_GROUPS_MOE, D_MODEL, EXPERTS_PER_GROUP), D_MODEL ** -0.5),
        "router_expert_b": nrm(ks[15], (L, N_GROUPS_MOE, EXPERTS_PER_GROUP), 0.01),
        "expert_w_gate": nrm(ks[16], (L, N_EXPERTS, D_MODEL, EXPERT_FF), D_MODEL ** -0.5),
        "expert_w_up": nrm(ks[17], (L, N_EXPERTS, D_MODEL, EXPERT_FF), D_MODEL ** -0.5),
        "expert_w_down": nrm(ks[18], (L, N_EXPERTS, EXPERT_FF, D_MODEL), EXPERT_FF ** -0.5),
        "final_norm_g": 1.0 + nrm(ks[19], (D_MODEL,), 0.02),
    }


def reference(x, attn_norm_g, w_in, gm_v_norm_g, gm_w_spatial, gm_b_spatial, attn_sinks,
              rel_bias, w_proj_a, w_proj_b, w_out, ffn_norm_g, router_group_w, router_group_b,
              router_expert_w, router_expert_b, expert_w_gate, expert_w_up, expert_w_down,
              final_norm_g):
    h = x
    for l in range(DEPTH):
        hn = rms_norm(h, attn_norm_g[l])
        proj = hn @ w_in[l]
        u_raw, v_raw, q, k, v, gate_a, gate_b = jnp.split(proj, SPLIT_POINTS, axis=-1)
        a = gmlp_chunk_mixer(u_raw, v_raw, gm_v_norm_g[l], gm_w_spatial[l], gm_b_spatial[l])
        b = swa_sink_attention(q, k, v, attn_sinks[l], rel_bias)
        merged = (jax.nn.sigmoid(gate_a) * (a @ w_proj_a[l])
                  + jax.nn.sigmoid(gate_b) * (b @ w_proj_b[l]))
        h = h + merged @ w_out[l]
        hn = rms_norm(h, ffn_norm_g[l])
        h = h + hierarchical_moe(hn, router_group_w[l], router_group_b[l], router_expert_w[l],
                                 router_expert_b[l], expert_w_gate[l], expert_w_up[l],
                                 expert_w_down[l])
    return rms_norm(h, final_norm_g)
```

```cpp
#include <hip/hip_runtime.h>
#include <stdint.h>
#include <stdio.h>

typedef unsigned short bf16_t;
typedef short bf16x8 __attribute__((ext_vector_type(8)));
typedef float f32x4 __attribute__((ext_vector_type(4)));
typedef unsigned u32x4 __attribute__((ext_vector_type(4)));

constexpr int T = 32768, D = 1024, SEQ = 4096, NIN = 3840;
constexpr int GMW = 512, AW = 512, KVW = 128, FF = 512, NEXP = 16, NCLS = 24;
constexpr float EPS = 1e-6f;
constexpr float LOG2E = 1.4426950408889634f;

constexpr size_t MiB = 1u << 20;
constexpr size_t WS_CTL = 0, CTL_BYTES = 1 * MiB;
constexpr size_t WS_WIN = 1 * MiB;
constexpr size_t WS_WPA = 9 * MiB;
constexpr size_t WS_WPB = 10 * MiB;
constexpr size_t WS_WOUT = 11 * MiB;
constexpr size_t WS_WUP = 13 * MiB;
constexpr size_t WS_WDN = 45 * MiB;
constexpr size_t WS_WSB = 61 * MiB;
constexpr size_t WS_BIAS = 62 * MiB;
constexpr size_t WS_HN = 64 * MiB;
constexpr size_t WS_U = 128 * MiB, WS_V = 160 * MiB, WS_Q = 192 * MiB, WS_K = 224 * MiB, WS_VV = 232 * MiB;
constexpr size_t WS_GA = 240 * MiB, WS_GB = 304 * MiB;
constexpr size_t WS_A = 368 * MiB, WS_B = 400 * MiB;
constexpr size_t WS_H = 128 * MiB;
constexpr size_t WS_HID = 256 * MiB;
constexpr size_t WS_VSTAT = 432 * MiB;
constexpr size_t WS_LIST = 434 * MiB;
constexpr size_t WS_WL = 437 * MiB;
constexpr size_t WS_VN = 445 * MiB;
constexpr size_t WS_END = 509 * MiB;
constexpr int CW_CNT = 64;
constexpr int CW_OFF = 1024;

__device__ __forceinline__ float bf2f(bf16_t v) { return __uint_as_float((unsigned)v << 16); }
__device__ __forceinline__ bf16_t f2bf(float f) { unsigned u = __float_as_uint(f); return (bf16_t)((u + 0x7fffu + ((u >> 16) & 1u)) >> 16); }
__device__ __forceinline__ float wave_sum(float v) {
#pragma unroll
    for (int o = 1; o < 64; o <<= 1) v += __shfl_xor(v, o);
    return v;
}
__device__ __forceinline__ float wave_max(float v) {
#pragma unroll
    for (int o = 1; o < 64; o <<= 1) v = fmaxf(v, __shfl_xor(v, o));
    return v;
}
__device__ __forceinline__ float gelu_tanh(float x) {
    const float u = 0.7978845608028654f * (x + 0.044715f * x * x * x);
    const float e = __expf(2.f * u);
    const float th = 1.f - 2.f / (1.f + e);
    return 0.5f * x * (1.f + th);
}
__device__ __forceinline__ float sigmoidf_(float x) { return 1.f / (1.f + __expf(-x)); }

__device__ const unsigned char kBucket[128] = {
    0, 1, 2, 3, 4, 5, 6, 7, 8, 9, 10, 11, 12, 13, 14, 15, 16, 16, 16, 17, 17, 18, 18, 18, 19, 19, 19, 20, 20, 20, 20, 21, 21, 21, 21, 22, 22, 22, 22, 22,
    23, 23, 23, 23, 23, 23, 24, 24, 24, 24, 24, 24, 25, 25, 25, 25, 25, 25, 25, 26, 26, 26, 26, 26, 26, 26, 26, 27, 27, 27, 27, 27, 27, 27, 27, 27, 27,
    28, 28, 28, 28, 28, 28, 28, 28, 28, 28, 29, 29, 29, 29, 29, 29, 29, 29, 29, 29, 29, 29, 30, 30, 30, 30, 30, 30, 30, 30, 30, 30, 30, 30, 30, 30,
    31, 31, 31, 31, 31, 31, 31, 31, 31, 31, 31, 31, 31, 31, 31};

__global__ __launch_bounds__(256) void k_transpose_convert(const float* __restrict__ W, int K, int N, bf16_t* __restrict__ WT, int ldk, int row_off, int blk, int blk_stride) {
    __shared__ float tile[32][33];
    const int n0 = blockIdx.x * 32, k0 = blockIdx.y * 32, tx = threadIdx.x & 31, ty = threadIdx.x >> 5;
    for (int i = ty; i < 32; i += 8) tile[i][tx] = W[(size_t)(k0 + i) * N + n0 + tx];
    __syncthreads();
    for (int i = ty; i < 32; i += 8) { const int n = n0 + i; const int row = row_off + (n / blk) * blk_stride + (n % blk);
        WT[(size_t)row * ldk + k0 + tx] = f2bf(tile[tx][i]); }
}
__global__ __launch_bounds__(256) void k_small_tables(const float* __restrict__ ws_in, const float* __restrict__ rel_bias, bf16_t* __restrict__ wsb, float* __restrict__ biasT) {
    const int i = blockIdx.x * 256 + threadIdx.x;
    if (i < 8 * 128 * 128) { const int s = i & 127, t = (i >> 7) & 127; wsb[i] = (s <= t) ? f2bf(ws_in[i]) : (bf16_t)0; }
    if (i < 8 * 128) { const int h = i >> 7, dist = i & 127; biasT[i] = rel_bias[kBucket[dist] * 8 + h] * LOG2E; }
}
__global__ __launch_bounds__(256) void k_rmsnorm_bf16(const float* __restrict__ x, const float* __restrict__ g, bf16_t* __restrict__ out) {
    const int row = blockIdx.x * 4 + (threadIdx.x >> 6), lane = threadIdx.x & 63;
    const f32x4* xr = (const f32x4*)(x + (size_t)row * D);
    f32x4 v[4]; float s = 0.f;
#pragma unroll
    for (int j = 0; j < 4; ++j) { v[j] = xr[lane + 64 * j]; s += v[j].x * v[j].x + v[j].y * v[j].y + v[j].z * v[j].z + v[j].w * v[j].w; }
    const float rstd = rsqrtf(wave_sum(s) * (1.f / D) + EPS);
#pragma unroll
    for (int j = 0; j < 4; ++j) { const f32x4 gv = ((const f32x4*)g)[lane + 64 * j];
        ushort4 o; o.x = f2bf(v[j].x * rstd * gv.x); o.y = f2bf(v[j].y * rstd * gv.y); o.z = f2bf(v[j].z * rstd * gv.z); o.w = f2bf(v[j].w * rstd * gv.w);
        ((ushort4*)(out + (size_t)row * D))[lane + 64 * j] = o; }
}

template <int MODE, class Op>
__global__ __launch_bounds__(256) void k_gemm_simple(Op op) {
    if (!op.active()) return;
    const int wave = threadIdx.x >> 6, lane = threadIdx.x & 63, wy = wave >> 1, wx = wave & 1, fr = lane & 15, fq = lane >> 4;
    const int row0 = blockIdx.y * 64 + wy * 32, col0 = blockIdx.x * 64 + wx * 32;
    f32x4 acc[2][2][2];
#pragma unroll
    for (int s = 0; s < 2; ++s)
#pragma unroll
        for (int i = 0; i < 2; ++i)
#pragma unroll
            for (int j = 0; j < 2; ++j) acc[s][i][j] = (f32x4){0.f, 0.f, 0.f, 0.f};
#pragma unroll
    for (int seg = 0; seg < (MODE == 0 ? 1 : 2); ++seg) {
        const bf16_t* ap[2]; const bf16_t* bp[2];
#pragma unroll
        for (int i = 0; i < 2; ++i) { ap[i] = op.arow(seg, row0 + i * 16 + fr) + fq * 8; bp[i] = op.brow(seg, col0 + i * 16 + fr) + fq * 8; }
        const int K = op.K(seg);
        for (int k = 0; k < K; k += 32) {
            bf16x8 a[2], b[2];
#pragma unroll
            for (int i = 0; i < 2; ++i) { a[i] = *(const bf16x8*)(ap[i] + k); b[i] = *(const bf16x8*)(bp[i] + k); }
#pragma unroll
            for (int i = 0; i < 2; ++i)
#pragma unroll
                for (int j = 0; j < 2; ++j) {
                    if (MODE == 2 && seg == 1) acc[1][i][j] = __builtin_amdgcn_mfma_f32_16x16x32_bf16(a[i], b[j], acc[1][i][j], 0, 0, 0);
                    else acc[0][i][j] = __builtin_amdgcn_mfma_f32_16x16x32_bf16(a[i], b[j], acc[0][i][j], 0, 0, 0);
                }
        }
    }
#pragma unroll
    for (int i = 0; i < 2; ++i)
#pragma unroll
        for (int j = 0; j < 2; ++j)
#pragma unroll
            for (int r = 0; r < 4; ++r) op.epi(row0 + i * 16 + fq * 4 + r, col0 + j * 16 + fr, acc[0][i][j][r], acc[1][i][j][r]);
}

struct OpG1 {
    const bf16_t* hn; const bf16_t* wt; bf16_t *U, *V, *Q, *Kb, *VV, *GA, *GB;
    __device__ bool active() const { return true; }
    __device__ int K(int) const { return D; }
    __device__ const bf16_t* arow(int, int r) const { return hn + (size_t)r * D; }
    __device__ const bf16_t* brow(int, int c) const { return wt + (size_t)c * D; }
    __device__ void epi(int r, int c, float v, float) const {
        if (c < 512) U[(size_t)r * 512 + c] = f2bf(gelu_tanh(v));
        else if (c < 1024) V[(size_t)r * 512 + (c - 512)] = f2bf(gelu_tanh(v));
        else if (c < 1536) Q[(size_t)r * 512 + (c - 1024)] = f2bf(v * (0.125f * LOG2E));
        else if (c < 1664) Kb[(size_t)r * 128 + (c - 1536)] = f2bf(v);
        else if (c < 1792) VV[(size_t)r * 128 + (c - 1664)] = f2bf(v);
        else if (c < 2816) GA[(size_t)r * 1024 + (c - 1792)] = f2bf(sigmoidf_(v));
        else GB[(size_t)r * 1024 + (c - 2816)] = f2bf(sigmoidf_(v));
    }
};
__global__ __launch_bounds__(256) void k_vstat_simple(const bf16_t* __restrict__ V, float* __restrict__ vstat) {
    const int row = blockIdx.x * 4 + (threadIdx.x >> 6), lane = threadIdx.x & 63;
    float s = 0.f, q = 0.f;
    for (int j = 0; j < 8; ++j) { const float v = bf2f(V[(size_t)row * 512 + lane + 64 * j]); s += v; q += v * v; }
    s = wave_sum(s); q = wave_sum(q);
    if (lane < 16) vstat[(size_t)row * 16 + lane] = lane == 0 ? s : (lane == 1 ? q : 0.f);
}
__global__ __launch_bounds__(256) void k_vnorm_simple(const bf16_t* __restrict__ V, const float* __restrict__ vstat, const float* __restrict__ gv, float* __restrict__ vn) {
    const int row = blockIdx.x * 4 + (threadIdx.x >> 6), lane = threadIdx.x & 63;
    float s = 0.f, q = 0.f;
    for (int p = 0; p < 8; ++p) { s += vstat[(size_t)row * 16 + 2 * p]; q += vstat[(size_t)row * 16 + 2 * p + 1]; }
    const float mean = s * (1.f / 512.f), var = fmaxf(q * (1.f / 512.f) - mean * mean, 0.f), rstd = rsqrtf(var + EPS);
    for (int j = 0; j < 8; ++j) { const int c = lane + 64 * j; vn[(size_t)row * 512 + c] = (bf2f(V[(size_t)row * 512 + c]) - mean) * rstd * gv[c]; }
}
__global__ __launch_bounds__(256) void k_gmlp_simple(const bf16_t* __restrict__ U, const float* __restrict__ vn, const bf16_t* __restrict__ wsb, const float* __restrict__ bs, bf16_t* __restrict__ A) {
    const int t = blockIdx.x, tl = t & 127, c0 = t - tl;
    for (int ch = threadIdx.x; ch < 512; ch += 256) {
        const int g = ch >> 6; float acc = 0.f;
        for (int s = 0; s <= tl; ++s) acc += bf2f(wsb[(g * 128 + tl) * 128 + s]) * vn[(size_t)(c0 + s) * 512 + ch];
        const float sv = acc + bs[g * 128 + tl];
        A[(size_t)t * 512 + ch] = f2bf(bf2f(U[(size_t)t * 512 + ch]) * sv);
    }
}
__global__ __launch_bounds__(256) void k_attn_simple(const bf16_t* __restrict__ Q, const bf16_t* __restrict__ Kb, const bf16_t* __restrict__ VV, const float* __restrict__ biasT,
                                                     const float* __restrict__ sinks, bf16_t* __restrict__ B) {
    const int w = blockIdx.x * 4 + (threadIdx.x >> 6), lane = threadIdx.x & 63;
    const int t = w >> 3, h = w & 7, kh = h >> 2, pos = t & (SEQ - 1), bb = t - pos;
    float sc[2]; float m = sinks[h] * LOG2E; const float sink2 = m;
#pragma unroll
    for (int u = 0; u < 2; ++u) {
        const int j = lane + 64 * u, kpos = pos - 127 + j, dist = 127 - j;
        float s = -1e30f;
        if (kpos >= 0) { float a = 0.f; const bf16_t* qp = Q + (size_t)t * 512 + h * 64; const bf16_t* kp = Kb + (size_t)(bb + kpos) * 128 + kh * 64;
            for (int d = 0; d < 64; ++d) a += bf2f(qp[d]) * bf2f(kp[d]);
            s = a + biasT[h * 128 + dist]; }
        sc[u] = s; m = fmaxf(m, s);
    }
    m = wave_max(m);
    float p0 = exp2f(sc[0] - m), p1 = exp2f(sc[1] - m);
    const float denom = wave_sum(p0 + p1) + exp2f(sink2 - m);
    p0 /= denom; p1 /= denom;
    float o = 0.f;
    for (int j = 0; j < 128; ++j) { const float p = __shfl(j < 64 ? p0 : p1, j & 63); const int kpos = pos - 127 + j;
        if (kpos >= 0) o += p * bf2f(VV[(size_t)(bb + kpos) * 128 + kh * 64 + lane]); }
    B[(size_t)t * 512 + h * 64 + lane] = f2bf(o);
}
struct OpG3 {
    const bf16_t *A, *B, *wpa, *wpb, *GA, *GB; bf16_t* M;
    __device__ bool active() const { return true; }
    __device__ int K(int) const { return 512; }
    __device__ const bf16_t* arow(int s, int r) const { return (s ? B : A) + (size_t)r * 512; }
    __device__ const bf16_t* brow(int s, int c) const { return (s ? wpb : wpa) + (size_t)c * 512; }
    __device__ void epi(int r, int c, float v1, float v2) const { const size_t i = (size_t)r * D + c; M[i] = f2bf(bf2f(GA[i]) * v1 + bf2f(GB[i]) * v2); }
};
struct OpG4 {
    const bf16_t *M, *wt; const float* x; float* H;
    __device__ bool active() const { return true; }
    __device__ int K(int) const { return D; }
    __device__ const bf16_t* arow(int, int r) const { return M + (size_t)r * D; }
    __device__ const bf16_t* brow(int, int c) const { return wt + (size_t)c * D; }
    __device__ void epi(int r, int c, float v, float) const { const size_t i = (size_t)r * D + c; H[i] = x[i] + v; }
};
__device__ __forceinline__ void route_token(const float (&lg)[20], const float* __restrict__ rgb, const float* __restrict__ reb, int& cls, float& wa, float& wb) {
    float gl[4]; float gm = -1e30f; int gi = 0;
#pragma unroll
    for (int i = 0; i < 4; ++i) { gl[i] = lg[i] + rgb[i]; if (gl[i] > gm) { gm = gl[i]; gi = i; } }
    float gs = 0.f;
#pragma unroll
    for (int i = 0; i < 4; ++i) gs += __expf(gl[i] - gm);
    const float gp = 1.f / gs;
    float el[4];
#pragma unroll
    for (int i = 0; i < 4; ++i) { float v = 0.f;
#pragma unroll
        for (int g = 0; g < 4; ++g) v = (g == gi) ? lg[4 + g * 4 + i] + reb[g * 4 + i] : v;
        el[i] = v; }
    int i1 = 0; float v1 = el[0];
#pragma unroll
    for (int i = 1; i < 4; ++i) if (el[i] > v1) { v1 = el[i]; i1 = i; }
    int i2 = -1; float v2 = -1e30f;
#pragma unroll
    for (int i = 0; i < 4; ++i) if (i != i1 && (i2 < 0 || el[i] > v2)) { v2 = el[i]; i2 = i; }
    const float e2 = __expf(v2 - v1), w1 = gp / (1.f + e2), w2 = gp * e2 / (1.f + e2);
    const int a = i1 < i2 ? i1 : i2, b = i1 < i2 ? i2 : i1;
    const int pi = (a == 0) ? (b - 1) : ((a == 1) ? (b + 1) : 5);
    cls = gi * 6 + pi; wa = (i1 < i2) ? w1 : w2; wb = (i1 < i2) ? w2 : w1;
}
__global__ __launch_bounds__(256) void k_router_simple(const float* __restrict__ H, const float* __restrict__ g2, const float* __restrict__ rgw, const float* __restrict__ rgb,
                                                       const float* __restrict__ rew, const float* __restrict__ reb, bf16_t* __restrict__ HN2, unsigned* __restrict__ ctl,
                                                       int* __restrict__ list, float* __restrict__ wl) {
    const int row = blockIdx.x * 4 + (threadIdx.x >> 6), lane = threadIdx.x & 63;
    const f32x4* xr = (const f32x4*)(H + (size_t)row * D);
    f32x4 v[4]; float s = 0.f;
#pragma unroll
    for (int j = 0; j < 4; ++j) { v[j] = xr[lane + 64 * j]; s += v[j].x * v[j].x + v[j].y * v[j].y + v[j].z * v[j].z + v[j].w * v[j].w; }
    const float rstd = rsqrtf(wave_sum(s) * (1.f / D) + EPS);
    float lg[20];
#pragma unroll
    for (int o = 0; o < 20; ++o) lg[o] = 0.f;
#pragma unroll
    for (int j = 0; j < 4; ++j) { const f32x4 gv = ((const f32x4*)g2)[lane + 64 * j];
        f32x4 n; n.x = v[j].x * rstd * gv.x; n.y = v[j].y * rstd * gv.y; n.z = v[j].z * rstd * gv.z; n.w = v[j].w * rstd * gv.w;
        ushort4 o; o.x = f2bf(n.x); o.y = f2bf(n.y); o.z = f2bf(n.z); o.w = f2bf(n.w);
        ((ushort4*)(HN2 + (size_t)row * D))[lane + 64 * j] = o;
#pragma unroll
        for (int e = 0; e < 4; ++e) { const int c = 4 * (lane + 64 * j) + e; const float hv = n[e];
            const f32x4 wg = *(const f32x4*)(rgw + (size_t)c * 4);
            lg[0] += hv * wg.x; lg[1] += hv * wg.y; lg[2] += hv * wg.z; lg[3] += hv * wg.w;
#pragma unroll
            for (int g = 0; g < 4; ++g) { const f32x4 we = *(const f32x4*)(rew + ((size_t)g * D + c) * 4);
                lg[4 + g * 4 + 0] += hv * we.x; lg[4 + g * 4 + 1] += hv * we.y; lg[4 + g * 4 + 2] += hv * we.z; lg[4 + g * 4 + 3] += hv * we.w; } } }
#pragma unroll
    for (int o = 0; o < 20; ++o) lg[o] = wave_sum(lg[o]);
    if (lane == 0) { int cls; float wa, wb; route_token(lg, rgb, reb, cls, wa, wb);
        const unsigned rank = atomicAdd(ctl + CW_CNT + 16 * cls, 1u);
        list[(size_t)cls * T + rank] = row; wl[((size_t)cls * T + rank) * 2] = wa; wl[((size_t)cls * T + rank) * 2 + 1] = wb; }
}
__global__ void k_class_offsets(unsigned* ctl) {
    if (threadIdx.x == 0 && blockIdx.x == 0) { unsigned off = 0; for (int c = 0; c < NCLS; ++c) { ctl[CW_OFF + c] = off; off += (ctl[CW_CNT + 16 * c] + 255u) & ~255u; } ctl[CW_OFF + NCLS] = off; }
}
__device__ __forceinline__ void class_experts(int cls, int& e1, int& e2) {
    const int g = cls / 6, pi = cls % 6; const int a = pi < 3 ? 0 : (pi < 5 ? 1 : 2); const int b = pi < 3 ? pi + 1 : (pi < 5 ? pi - 1 : 3);
    e1 = 4 * g + a; e2 = 4 * g + b;
}
struct OpUp {
    const bf16_t *HN2, *wup; const unsigned* ctl; const int* list; const float* wl; bf16_t* HID;
    __device__ bool active() const { return blockIdx.y * 64u < ctl[CW_CNT + 16 * blockIdx.z]; }
    __device__ int K(int) const { return D; }
    __device__ const bf16_t* arow(int, int r) const { const int cls = blockIdx.z; const unsigned cnt = ctl[CW_CNT + 16 * cls]; const int t = (unsigned)r < cnt ? list[(size_t)cls * T + r] : 0; return HN2 + (size_t)t * D; }
    __device__ const bf16_t* brow(int s, int c) const { int e1, e2; class_experts(blockIdx.z, e1, e2); const int e = c < 512 ? e1 : e2, hc = c & 511;
        return wup + ((size_t)e * 1024 + (hc >> 7) * 256 + s * 128 + (hc & 127)) * D; }
    __device__ void epi(int r, int c, float g, float u) const { const int cls = blockIdx.z; const unsigned cnt = ctl[CW_CNT + 16 * cls];
        if ((unsigned)r < cnt) { const float w = wl[((size_t)cls * T + r) * 2 + (c >> 9)]; HID[((size_t)ctl[CW_OFF + cls] + r) * 1024 + c] = f2bf(w * (g / (1.f + __expf(-g))) * u); } }
};
struct OpDown {
    const bf16_t *HID, *wdn; const unsigned* ctl; const int* list; const float* H; float* OUT;
    __device__ bool active() const { return blockIdx.y * 64u < ctl[CW_CNT + 16 * blockIdx.z]; }
    __device__ int K(int) const { return 512; }
    __device__ const bf16_t* arow(int s, int r) const { return HID + ((size_t)ctl[CW_OFF + blockIdx.z] + r) * 1024 + s * 512; }
    __device__ const bf16_t* brow(int s, int c) const { int e1, e2; class_experts(blockIdx.z, e1, e2); return wdn + ((size_t)(s ? e2 : e1) * 1024 + c) * 512; }
    __device__ void epi(int r, int c, float v, float) const { const int cls = blockIdx.z; const unsigned cnt = ctl[CW_CNT + 16 * cls];
        if ((unsigned)r < cnt) { const int t = list[(size_t)cls * T + r]; const size_t i = (size_t)t * D + c; OUT[i] = H[i] + v; } }
};
__global__ __launch_bounds__(256) void k_final_norm(float* __restrict__ out, const float* __restrict__ g) {
    const int row = blockIdx.x * 4 + (threadIdx.x >> 6), lane = threadIdx.x & 63;
    f32x4* xr = (f32x4*)(out + (size_t)row * D);
    f32x4 v[4]; float s = 0.f;
#pragma unroll
    for (int j = 0; j < 4; ++j) { v[j] = xr[lane + 64 * j]; s += v[j].x * v[j].x + v[j].y * v[j].y + v[j].z * v[j].z + v[j].w * v[j].w; }
    const float rstd = rsqrtf(wave_sum(s) * (1.f / D) + EPS);
#pragma unroll
    for (int j = 0; j < 4; ++j) { const f32x4 gv = ((const f32x4*)g)[lane + 64 * j]; f32x4 o; o.x = v[j].x * rstd * gv.x; o.y = v[j].y * rstd * gv.y; o.z = v[j].z * rstd * gv.z; o.w = v[j].w * rstd * gv.w; xr[lane + 64 * j] = o; }
}

extern "C" void kernel_launch(void* const* d_in, const int* in_sizes, int n_in, void* d_out, int out_size, void* d_ws, size_t ws_size, hipStream_t stream) {
    if (n_in != 20 || out_size != T * D || ws_size < WS_END) { fprintf(stderr, "kernel_launch: unexpected shapes (n_in %d out %d ws %zu)\n", n_in, out_size, ws_size); return; }
    const float* x = (const float*)d_in[0]; const float* g1 = (const float*)d_in[1]; const float* w_in = (const float*)d_in[2]; const float* gv = (const float*)d_in[3];
    const float* wsp = (const float*)d_in[4]; const float* bsp = (const float*)d_in[5]; const float* sinks = (const float*)d_in[6]; const float* relb = (const float*)d_in[7];
    const float* wpa = (const float*)d_in[8]; const float* wpb = (const float*)d_in[9]; const float* wout = (const float*)d_in[10]; const float* g2 = (const float*)d_in[11];
    const float* rgw = (const float*)d_in[12]; const float* rgb = (const float*)d_in[13]; const float* rew = (const float*)d_in[14]; const float* reb = (const float*)d_in[15];
    const float* wg = (const float*)d_in[16]; const float* wu = (const float*)d_in[17]; const float* wd = (const float*)d_in[18]; const float* gf = (const float*)d_in[19];
    unsigned char* ws = (unsigned char*)d_ws; float* out = (float*)d_out;
    unsigned* ctl = (unsigned*)(ws + WS_CTL);
    bf16_t* WIN = (bf16_t*)(ws + WS_WIN); bf16_t* WPA = (bf16_t*)(ws + WS_WPA); bf16_t* WPB = (bf16_t*)(ws + WS_WPB); bf16_t* WOUT = (bf16_t*)(ws + WS_WOUT);
    bf16_t* WUP = (bf16_t*)(ws + WS_WUP); bf16_t* WDN = (bf16_t*)(ws + WS_WDN); bf16_t* WSB = (bf16_t*)(ws + WS_WSB); float* BIAS = (float*)(ws + WS_BIAS);
    bf16_t* HN = (bf16_t*)(ws + WS_HN); bf16_t* U = (bf16_t*)(ws + WS_U); bf16_t* V = (bf16_t*)(ws + WS_V); bf16_t* Q = (bf16_t*)(ws + WS_Q); bf16_t* Kb = (bf16_t*)(ws + WS_K);
    bf16_t* VV = (bf16_t*)(ws + WS_VV); bf16_t* GA = (bf16_t*)(ws + WS_GA); bf16_t* GB = (bf16_t*)(ws + WS_GB); bf16_t* A = (bf16_t*)(ws + WS_A); bf16_t* B = (bf16_t*)(ws + WS_B);
    float* H = (float*)(ws + WS_H); bf16_t* HID = (bf16_t*)(ws + WS_HID); float* VSTAT = (float*)(ws + WS_VSTAT); int* LIST = (int*)(ws + WS_LIST); float* WL = (float*)(ws + WS_WL);
    float* VN = (float*)(ws + WS_VN); bf16_t* MERGED = HN; bf16_t* HN2 = HN;

    hipMemsetAsync(ws + WS_CTL, 0, CTL_BYTES, stream);
    k_transpose_convert<<<dim3(NIN / 32, D / 32), 256, 0, stream>>>(w_in, D, NIN, WIN, D, 0, NIN, NIN);
    k_transpose_convert<<<dim3(D / 32, 512 / 32), 256, 0, stream>>>(wpa, 512, D, WPA, 512, 0, D, D);
    k_transpose_convert<<<dim3(D / 32, 512 / 32), 256, 0, stream>>>(wpb, 512, D, WPB, 512, 0, D, D);
    k_transpose_convert<<<dim3(D / 32, D / 32), 256, 0, stream>>>(wout, D, D, WOUT, D, 0, D, D);
    for (int e = 0; e < NEXP; ++e) {
        k_transpose_convert<<<dim3(FF / 32, D / 32), 256, 0, stream>>>(wg + (size_t)e * D * FF, D, FF, WUP + (size_t)e * 1024 * D, D, 0, 128, 256);
        k_transpose_convert<<<dim3(FF / 32, D / 32), 256, 0, stream>>>(wu + (size_t)e * D * FF, D, FF, WUP + (size_t)e * 1024 * D, D, 128, 128, 256);
        k_transpose_convert<<<dim3(D / 32, FF / 32), 256, 0, stream>>>(wd + (size_t)e * FF * D, FF, D, WDN + (size_t)e * 1024 * FF, FF, 0, D, D);
    }
    k_small_tables<<<512, 256, 0, stream>>>(wsp, relb, WSB, BIAS);
    k_rmsnorm_bf16<<<T / 4, 256, 0, stream>>>(x, g1, HN);
    { OpG1 op{HN, WIN, U, V, Q, Kb, VV, GA, GB}; k_gemm_simple<0, OpG1><<<dim3(NIN / 64, T / 64), 256, 0, stream>>>(op); }
    k_vstat_simple<<<T / 4, 256, 0, stream>>>(V, VSTAT);
    k_vnorm_simple<<<T / 4, 256, 0, stream>>>(V, VSTAT, gv, VN);
    k_gmlp_simple<<<T, 256, 0, stream>>>(U, VN, WSB, bsp, A);
    k_attn_simple<<<T * 8 / 4, 256, 0, stream>>>(Q, Kb, VV, BIAS, sinks, B);
    { OpG3 op{A, B, WPA, WPB, GA, GB, MERGED}; k_gemm_simple<2, OpG3><<<dim3(D / 64, T / 64), 256, 0, stream>>>(op); }
    { OpG4 op{MERGED, WOUT, x, H}; k_gemm_simple<0, OpG4><<<dim3(D / 64, T / 64), 256, 0, stream>>>(op); }
    k_router_simple<<<T / 4, 256, 0, stream>>>(H, g2, rgw, rgb, rew, reb, HN2, ctl, LIST, WL);
    k_class_offsets<<<1, 64, 0, stream>>>(ctl);
    { OpUp op{HN2, WUP, ctl, LIST, WL, HID}; k_gemm_simple<2, OpUp><<<dim3(1024 / 64, T / 64, NCLS), 256, 0, stream>>>(op); }
    { OpDown op{HID, WDN, ctl, LIST, H, out}; k_gemm_simple<1, OpDown><<<dim3(D / 64, T / 64, NCLS), 256, 0, stream>>>(op); }
    k_final_norm<<<T / 4, 256, 0, stream>>>(out, gf);
}
```

```cpp
#include <hip/hip_runtime.h>
#include <stdint.h>
#include <stdio.h>

typedef unsigned short bf16_t;
typedef short bf16x8 __attribute__((ext_vector_type(8)));
typedef float f32x4 __attribute__((ext_vector_type(4)));
typedef unsigned u32x4 __attribute__((ext_vector_type(4)));

constexpr int T = 32768, D = 1024, SEQ = 4096, NIN = 3840;
constexpr int GMW = 512, AW = 512, KVW = 128, FF = 512, NEXP = 16, NCLS = 24;
constexpr float EPS = 1e-6f;
constexpr float LOG2E = 1.4426950408889634f;

constexpr size_t MiB = 1u << 20;
constexpr size_t WS_CTL = 0, CTL_BYTES = 1 * MiB;
constexpr size_t WS_WIN = 1 * MiB;
constexpr size_t WS_WPA = 9 * MiB;
constexpr size_t WS_WPB = 10 * MiB;
constexpr size_t WS_WOUT = 11 * MiB;
constexpr size_t WS_WUP = 13 * MiB;
constexpr size_t WS_WDN = 45 * MiB;
constexpr size_t WS_WSB = 61 * MiB;
constexpr size_t WS_BIAS = 62 * MiB;
constexpr size_t WS_HN = 64 * MiB;
constexpr size_t WS_U = 128 * MiB, WS_V = 160 * MiB, WS_Q = 192 * MiB, WS_K = 224 * MiB, WS_VV = 232 * MiB;
constexpr size_t WS_GA = 240 * MiB, WS_GB = 304 * MiB;
constexpr size_t WS_A = 368 * MiB, WS_B = 400 * MiB;
constexpr size_t WS_H = 128 * MiB;
constexpr size_t WS_HID = 256 * MiB;
constexpr size_t WS_VSTAT = 432 * MiB;
constexpr size_t WS_LIST = 434 * MiB;
constexpr size_t WS_WL = 437 * MiB;
constexpr size_t WS_VN = 445 * MiB;
constexpr size_t WS_END = 509 * MiB;
constexpr int CW_CNT = 64;
constexpr int CW_OFF = 1024;

__device__ __forceinline__ float bf2f(bf16_t v) { return __uint_as_float((unsigned)v << 16); }
__device__ __forceinline__ bf16_t f2bf(float f) { unsigned u = __float_as_uint(f); return (bf16_t)((u + 0x7fffu + ((u >> 16) & 1u)) >> 16); }
__device__ __forceinline__ float wave_sum(float v) {
#pragma unroll
    for (int o = 1; o < 64; o <<= 1) v += __shfl_xor(v, o);
    return v;
}
__device__ __forceinline__ float wave_max(float v) {
#pragma unroll
    for (int o = 1; o < 64; o <<= 1) v = fmaxf(v, __shfl_xor(v, o));
    return v;
}
__device__ __forceinline__ float gelu_tanh(float x) {
    const float u = 0.7978845608028654f * (x + 0.044715f * x * x * x);
    const float e = __expf(2.f * u);
    const float th = 1.f - 2.f / (1.f + e);
    return 0.5f * x * (1.f + th);
}
__device__ __forceinline__ float sigmoidf_(float x) { return 1.f / (1.f + __expf(-x)); }

__device__ const unsigned char kBucket[128] = {
    0, 1, 2, 3, 4, 5, 6, 7, 8, 9, 10, 11, 12, 13, 14, 15, 16, 16, 16, 17, 17, 18, 18, 18, 19, 19, 19, 20, 20, 20, 20, 21, 21, 21, 21, 22, 22, 22, 22, 22,
    23, 23, 23, 23, 23, 23, 24, 24, 24, 24, 24, 24, 25, 25, 25, 25, 25, 25, 25, 26, 26, 26, 26, 26, 26, 26, 26, 27, 27, 27, 27, 27, 27, 27, 27, 27, 27,
    28, 28, 28, 28, 28, 28, 28, 28, 28, 28, 29, 29, 29, 29, 29, 29, 29, 29, 29, 29, 29, 29, 30, 30, 30, 30, 30, 30, 30, 30, 30, 30, 30, 30, 30, 30,
    31, 31, 31, 31, 31, 31, 31, 31, 31, 31, 31, 31, 31, 31, 31};

__global__ __launch_bounds__(256) void k_transpose_convert(const float* __restrict__ W, int K, int N, bf16_t* __restrict__ WT, int ldk, int row_off, int blk, int blk_stride) {
    __shared__ float tile[32][33];
    const int n0 = blockIdx.x * 32, k0 = blockIdx.y * 32, tx = threadIdx.x & 31, ty = threadIdx.x >> 5;
    for (int i = ty; i < 32; i += 8) tile[i][tx] = W[(size_t)(k0 + i) * N + n0 + tx];
    __syncthreads();
    for (int i = ty; i < 32; i += 8) { const int n = n0 + i; const int row = row_off + (n / blk) * blk_stride + (n % blk);
        WT[(size_t)row * ldk + k0 + tx] = f2bf(tile[tx][i]); }
}
__global__ __launch_bounds__(256) void k_small_tables(const float* __restrict__ ws_in, const float* __restrict__ rel_bias, bf16_t* __restrict__ wsb, float* __restrict__ biasT) {
    const int i = blockIdx.x * 256 + threadIdx.x;
    if (i < 8 * 128 * 128) { const int s = i & 127, t = (i >> 7) & 127; wsb[i] = (s <= t) ? f2bf(ws_in[i]) : (bf16_t)0; }
    if (i < 8 * 128) { const int h = i >> 7, dist = i & 127; biasT[i] = rel_bias[kBucket[dist] * 8 + h] * LOG2E; }
}
__global__ __launch_bounds__(256) void k_rmsnorm_bf16(const float* __restrict__ x, const float* __restrict__ g, bf16_t* __restrict__ out) {
    const int row = blockIdx.x * 4 + (threadIdx.x >> 6), lane = threadIdx.x & 63;
    const f32x4* xr = (const f32x4*)(x + (size_t)row * D);
    f32x4 v[4]; float s = 0.f;
#pragma unroll
    for (int j = 0; j < 4; ++j) { v[j] = xr[lane + 64 * j]; s += v[j].x * v[j].x + v[j].y * v[j].y + v[j].z * v[j].z + v[j].w * v[j].w; }
    const float rstd = rsqrtf(wave_sum(s) * (1.f / D) + EPS);
#pragma unroll
    for (int j = 0; j < 4; ++j) { const f32x4 gv = ((const f32x4*)g)[lane + 64 * j];
        ushort4 o; o.x = f2bf(v[j].x * rstd * gv.x); o.y = f2bf(v[j].y * rstd * gv.y); o.z = f2bf(v[j].z * rstd * gv.z); o.w = f2bf(v[j].w * rstd * gv.w);
        ((ushort4*)(out + (size_t)row * D))[lane + 64 * j] = o; }
}

template <int MODE, class Op>
__global__ __launch_bounds__(256) void k_gemm_simple(Op op) {
    if (!op.active()) return;
    const int wave = threadIdx.x >> 6, lane = threadIdx.x & 63, wy = wave >> 1, wx = wave & 1, fr = lane & 15, fq = lane >> 4;
    const int row0 = blockIdx.y * 64 + wy * 32, col0 = blockIdx.x * 64 + wx * 32;
    f32x4 acc[2][2][2];
#pragma unroll
    for (int s = 0; s < 2; ++s)
#pragma unroll
        for (int i = 0; i < 2; ++i)
#pragma unroll
            for (int j = 0; j < 2; ++j) acc[s][i][j] = (f32x4){0.f, 0.f, 0.f, 0.f};
#pragma unroll
    for (int seg = 0; seg < (MODE == 0 ? 1 : 2); ++seg) {
        const bf16_t* ap[2]; const bf16_t* bp[2];
#pragma unroll
        for (int i = 0; i < 2; ++i) { ap[i] = op.arow(seg, row0 + i * 16 + fr) + fq * 8; bp[i] = op.brow(seg, col0 + i * 16 + fr) + fq * 8; }
        const int K = op.K(seg);
        for (int k = 0; k < K; k += 32) {
            bf16x8 a[2], b[2];
#pragma unroll
            for (int i = 0; i < 2; ++i) { a[i] = *(const bf16x8*)(ap[i] + k); b[i] = *(const bf16x8*)(bp[i] + k); }
#pragma unroll
            for (int i = 0; i < 2; ++i)
#pragma unroll
                for (int j = 0; j < 2; ++j) {
                    if (MODE == 2 && seg == 1) acc[1][i][j] = __builtin_amdgcn_mfma_f32_16x16x32_bf16(a[i], b[j], acc[1][i][j], 0, 0, 0);
                    else acc[0][i][j] = __builtin_amdgcn_mfma_f32_16x16x32_bf16(a[i], b[j], acc[0][i][j], 0, 0, 0);
                }
        }
    }
#pragma unroll
    for (int i = 0; i < 2; ++i)
#pragma unroll
        for (int j = 0; j < 2; ++j)
#pragma unroll
            for (int r = 0; r < 4; ++r) op.epi(row0 + i * 16 + fq * 4 + r, col0 + j * 16 + fr, acc[0][i][j][r], acc[1][i][j][r]);
}

struct OpG1 {
    const bf16_t* hn; const bf16_t* wt; bf16_t *U, *V, *Q, *Kb, *VV, *GA, *GB;
    __device__ bool active() const { return true; }
    __device__ int K(int) const { return D; }
    __device__ const bf16_t* arow(int, int r) const { return hn + (size_t)r * D; }
    __device__ const bf16_t* brow(int, int c) const { return wt + (size_t)c * D; }
    __device__ void epi(int r, int c, float v, float) const {
        if (c < 512) U[(size_t)r * 512 + c] = f2bf(gelu_tanh(v));
        else if (c < 1024) V[(size_t)r * 512 + (c - 512)] = f2bf(gelu_tanh(v));
        else if (c < 1536) Q[(size_t)r * 512 + (c - 1024)] = f2bf(v * (0.125f * LOG2E));
        else if (c < 1664) Kb[(size_t)r * 128 + (c - 1536)] = f2bf(v);
        else if (c < 1792) VV[(size_t)r * 128 + (c - 1664)] = f2bf(v);
        else if (c < 2816) GA[(size_t)r * 1024 + (c - 1792)] = f2bf(sigmoidf_(v));
        else GB[(size_t)r * 1024 + (c - 2816)] = f2bf(sigmoidf_(v));
    }
};
__global__ __launch_bounds__(256) void k_vstat_simple(const bf16_t* __restrict__ V, float* __restrict__ vstat) {
    const int row = blockIdx.x * 4 + (threadIdx.x >> 6), lane = threadIdx.x & 63;
    float s = 0.f, q = 0.f;
    for (int j = 0; j < 8; ++j) { const float v = bf2f(V[(size_t)row * 512 + lane + 64 * j]); s += v; q += v * v; }
    s = wave_sum(s); q = wave_sum(q);
    if (lane < 16) vstat[(size_t)row * 16 + lane] = lane == 0 ? s : (lane == 1 ? q : 0.f);
}
__global__ __launch_bounds__(256) void k_vnorm_simple(const bf16_t* __restrict__ V, const float* __restrict__ vstat, const float* __restrict__ gv, float* __restrict__ vn) {
    const int row = blockIdx.x * 4 + (threadIdx.x >> 6), lane = threadIdx.x & 63;
    float s = 0.f, q = 0.f;
    for (int p = 0; p < 8; ++p) { s += vstat[(size_t)row * 16 + 2 * p]; q += vstat[(size_t)row * 16 + 2 * p + 1]; }
    const float mean = s * (1.f / 512.f), var = fmaxf(q * (1.f / 512.f) - mean * mean, 0.f), rstd = rsqrtf(var + EPS);
    for (int j = 0; j < 8; ++j) { const int c = lane + 64 * j; vn[(size_t)row * 512 + c] = (bf2f(V[(size_t)row * 512 + c]) - mean) * rstd * gv[c]; }
}
__global__ __launch_bounds__(256) void k_gmlp_simple(const bf16_t* __restrict__ U, const float* __restrict__ vn, const bf16_t* __restrict__ wsb, const float* __restrict__ bs, bf16_t* __restrict__ A) {
    const int t = blockIdx.x, tl = t & 127, c0 = t - tl;
    for (int ch = threadIdx.x; ch < 512; ch += 256) {
        const int g = ch >> 6; float acc = 0.f;
        for (int s = 0; s <= tl; ++s) acc += bf2f(wsb[(g * 128 + tl) * 128 + s]) * vn[(size_t)(c0 + s) * 512 + ch];
        const float sv = acc + bs[g * 128 + tl];
        A[(size_t)t * 512 + ch] = f2bf(bf2f(U[(size_t)t * 512 + ch]) * sv);
    }
}
__global__ __launch_bounds__(256) void k_attn_simple(const bf16_t* __restrict__ Q, const bf16_t* __restrict__ Kb, const bf16_t* __restrict__ VV, const float* __restrict__ biasT,
                                                     const float* __restrict__ sinks, bf16_t* __restrict__ B) {
    const int w = blockIdx.x * 4 + (threadIdx.x >> 6), lane = threadIdx.x & 63;
    const int t = w >> 3, h = w & 7, kh = h >> 2, pos = t & (SEQ - 1), bb = t - pos;
    float sc[2]; float m = sinks[h] * LOG2E; const float sink2 = m;
#pragma unroll
    for (int u = 0; u < 2; ++u) {
        const int j = lane + 64 * u, kpos = pos - 127 + j, dist = 127 - j;
        float s = -1e30f;
        if (kpos >= 0) { float a = 0.f; const bf16_t* qp = Q + (size_t)t * 512 + h * 64; const bf16_t* kp = Kb + (size_t)(bb + kpos) * 128 + kh * 64;
            for (int d = 0; d < 64; ++d) a += bf2f(qp[d]) * bf2f(kp[d]);
            s = a + biasT[h * 128 + dist]; }
        sc[u] = s; m = fmaxf(m, s);
    }
    m = wave_max(m);
    float p0 = exp2f(sc[0] - m), p1 = exp2f(sc[1] - m);
    const float denom = wave_sum(p0 + p1) + exp2f(sink2 - m);
    p0 /= denom; p1 /= denom;
    float o = 0.f;
    for (int j = 0; j < 128; ++j) { const float p = __shfl(j < 64 ? p0 : p1, j & 63); const int kpos = pos - 127 + j;
        if (kpos >= 0) o += p * bf2f(VV[(size_t)(bb + kpos) * 128 + kh * 64 + lane]); }
    B[(size_t)t * 512 + h * 64 + lane] = f2bf(o);
}
struct OpG3 {
    const bf16_t *A, *B, *wpa, *wpb, *GA, *GB; bf16_t* M;
    __device__ bool active() const { return true; }
    __device__ int K(int) const { return 512; }
    __device__ const bf16_t* arow(int s, int r) const { return (s ? B : A) + (size_t)r * 512; }
    __device__ const bf16_t* brow(int s, int c) const { return (s ? wpb : wpa) + (size_t)c * 512; }
    __device__ void epi(int r, int c, float v1, float v2) const { const size_t i = (size_t)r * D + c; M[i] = f2bf(bf2f(GA[i]) * v1 + bf2f(GB[i]) * v2); }
};
struct OpG4 {
    const bf16_t *M, *wt; const float* x; float* H;
    __device__ bool active() const { return true; }
    __device__ int K(int) const { return D; }
    __device__ const bf16_t* arow(int, int r) const { return M + (size_t)r * D; }
    __device__ const bf16_t* brow(int, int c) const { return wt + (size_t)c * D; }
    __device__ void epi(int r, int c, float v, float) const { const size_t i = (size_t)r * D + c; H[i] = x[i] + v; }
};
__device__ __forceinline__ void route_token(const float (&lg)[20], const float* __restrict__ rgb, const float* __restrict__ reb, int& cls, float& wa, float& wb) {
    float gl[4]; float gm = -1e30f; int gi = 0;
#pragma unroll
    for (int i = 0; i < 4; ++i) { gl[i] = lg[i] + rgb[i]; if (gl[i] > gm) { gm = gl[i]; gi = i; } }
    float gs = 0.f;
#pragma unroll
    for (int i = 0; i < 4; ++i) gs += __expf(gl[i] - gm);
    const float gp = 1.f / gs;
    float el[4];
#pragma unroll
    for (int i = 0; i < 4; ++i) { float v = 0.f;
#pragma unroll
        for (int g = 0; g < 4; ++g) v = (g == gi) ? lg[4 + g * 4 + i] + reb[g * 4 + i] : v;
        el[i] = v; }
    int i1 = 0; float v1 = el[0];
#pragma unroll
    for (int i = 1; i < 4; ++i) if (el[i] > v1) { v1 = el[i]; i1 = i; }
    int i2 = -1; float v2 = -1e30f;
#pragma unroll
    for (int i = 0; i < 4; ++i) if (i != i1 && (i2 < 0 || el[i] > v2)) { v2 = el[i]; i2 = i; }
    const float e2 = __expf(v2 - v1), w1 = gp / (1.f + e2), w2 = gp * e2 / (1.f + e2);
    const int a = i1 < i2 ? i1 : i2, b = i1 < i2 ? i2 : i1;
    const int pi = (a == 0) ? (b - 1) : ((a == 1) ? (b + 1) : 5);
    cls = gi * 6 + pi; wa = (i1 < i2) ? w1 : w2; wb = (i1 < i2) ? w2 : w1;
}
__global__ __launch_bounds__(256) void k_router_simple(const float* __restrict__ H, const float* __restrict__ g2, const float* __restrict__ rgw, const float* __restrict__ rgb,
                                                       const float* __restrict__ rew, const float* __restrict__ reb, bf16_t* __restrict__ HN2, unsigned* __restrict__ ctl,
                                                       int* __restrict__ list, float* __restrict__ wl) {
    const int row = blockIdx.x * 4 + (threadIdx.x >> 6), lane = threadIdx.x & 63;
    const f32x4* xr = (const f32x4*)(H + (size_t)row * D);
    f32x4 v[4]; float s = 0.f;
#pragma unroll
    for (int j = 0; j < 4; ++j) { v[j] = xr[lane + 64 * j]; s += v[j].x * v[j].x + v[j].y * v[j].y + v[j].z * v[j].z + v[j].w * v[j].w; }
    const float rstd = rsqrtf(wave_sum(s) * (1.f / D) + EPS);
    float lg[20];
#pragma unroll
    for (int o = 0; o < 20; ++o) lg[o] = 0.f;
#pragma unroll
    for (int j = 0; j < 4; ++j) { const f32x4 gv = ((const f32x4*)g2)[lane + 64 * j];
        f32x4 n; n.x = v[j].x * rstd * gv.x; n.y = v[j].y * rstd * gv.y; n.z = v[j].z * rstd * gv.z; n.w = v[j].w * rstd * gv.w;
        ushort4 o; o.x = f2bf(n.x); o.y = f2bf(n.y); o.z = f2bf(n.z); o.w = f2bf(n.w);
        ((ushort4*)(HN2 + (size_t)row * D))[lane + 64 * j] = o;
#pragma unroll
        for (int e = 0; e < 4; ++e) { const int c = 4 * (lane + 64 * j) + e; const float hv = n[e];
            const f32x4 wg = *(const f32x4*)(rgw + (size_t)c * 4);
            lg[0] += hv * wg.x; lg[1] += hv * wg.y; lg[2] += hv * wg.z; lg[3] += hv * wg.w;
#pragma unroll
            for (int g = 0; g < 4; ++g) { const f32x4 we = *(const f32x4*)(rew + ((size_t)g * D + c) * 4);
                lg[4 + g * 4 + 0] += hv * we.x; lg[4 + g * 4 + 1] += hv * we.y; lg[4 + g * 4 + 2] += hv * we.z; lg[4 + g * 4 + 3] += hv * we.w; } } }
#pragma unroll
    for (int o = 0; o < 20; ++o) lg[o] = wave_sum(lg[o]);
    if (lane == 0) { int cls; float wa, wb; route_token(lg, rgb, reb, cls, wa, wb);
        const unsigned rank = atomicAdd(ctl + CW_CNT + 16 * cls, 1u);
        list[(size_t)cls * T + rank] = row; wl[((size_t)cls * T + rank) * 2] = wa; wl[((size_t)cls * T + rank) * 2 + 1] = wb; }
}
__global__ void k_class_offsets(unsigned* ctl) {
    if (threadIdx.x == 0 && blockIdx.x == 0) { unsigned off = 0; for (int c = 0; c < NCLS; ++c) { ctl[CW_OFF + c] = off; off += (ctl[CW_CNT + 16 * c] + 255u) & ~255u; } ctl[CW_OFF + NCLS] = off; }
}
__device__ __forceinline__ void class_experts(int cls, int& e1, int& e2) {
    const int g = cls / 6, pi = cls % 6; const int a = pi < 3 ? 0 : (pi < 5 ? 1 : 2); const int b = pi < 3 ? pi + 1 : (pi < 5 ? pi - 1 : 3);
    e1 = 4 * g + a; e2 = 4 * g + b;
}
struct OpUp {
    const bf16_t *HN2, *wup; const unsigned* ctl; const int* list; const float* wl; bf16_t* HID;
    __device__ bool active() const { return blockIdx.y * 64u < ctl[CW_CNT + 16 * blockIdx.z]; }
    __device__ int K(int) const { return D; }
    __device__ const bf16_t* arow(int, int r) const { const int cls = blockIdx.z; const unsigned cnt = ctl[CW_CNT + 16 * cls]; const int t = (unsigned)r < cnt ? list[(size_t)cls * T + r] : 0; return HN2 + (size_t)t * D; }
    __device__ const bf16_t* brow(int s, int c) const { int e1, e2; class_experts(blockIdx.z, e1, e2); const int e = c < 512 ? e1 : e2, hc = c & 511;
        return wup + ((size_t)e * 1024 + (hc >> 7) * 256 + s * 128 + (hc & 127)) * D; }
    __device__ void epi(int r, int c, float g, float u) const { const int cls = blockIdx.z; const unsigned cnt = ctl[CW_CNT + 16 * cls];
        if ((unsigned)r < cnt) { const float w = wl[((size_t)cls * T + r) * 2 + (c >> 9)]; HID[((size_t)ctl[CW_OFF + cls] + r) * 1024 + c] = f2bf(w * (g / (1.f + __expf(-g))) * u); } }
};
struct OpDown {
    const bf16_t *HID, *wdn; const unsigned* ctl; const int* list; const float* H; float* OUT;
    __device__ bool active() const { return blockIdx.y * 64u < ctl[CW_CNT + 16 * blockIdx.z]; }
    __device__ int K(int) const { return 512; }
    __device__ const bf16_t* arow(int s, int r) const { return HID + ((size_t)ctl[CW_OFF + blockIdx.z] + r) * 1024 + s * 512; }
    __device__ const bf16_t* brow(int s, int c) const { int e1, e2; class_experts(blockIdx.z, e1, e2); return wdn + ((size_t)(s ? e2 : e1) * 1024 + c) * 512; }
    __device__ void epi(int r, int c, float v, float) const { const int cls = blockIdx.z; const unsigned cnt = ctl[CW_CNT + 16 * cls];
        if ((unsigned)r < cnt) { const int t = list[(size_t)cls * T + r]; const size_t i = (size_t)t * D + c; OUT[i] = H[i] + v; } }
};
__global__ __launch_bounds__(256) void k_final_norm(float* __restrict__ out, const float* __restrict__ g) {
    const int row = blockIdx.x * 4 + (threadIdx.x >> 6), lane = threadIdx.x & 63;
    f32x4* xr = (f32x4*)(out + (size_t)row * D);
    f32x4 v[4]; float s = 0.f;
#pragma unroll
    for (int j = 0; j < 4; ++j) { v[j] = xr[lane + 64 * j]; s += v[j].x * v[j].x + v[j].y * v[j].y + v[j].z * v[j].z + v[j].w * v[j].w; }
    const float rstd = rsqrtf(wave_sum(s) * (1.f / D) + EPS);
#pragma unroll
    for (int j = 0; j < 4; ++j) { const f32x4 gv = ((const f32x4*)g)[lane + 64 * j]; f32x4 o; o.x = v[j].x * rstd * gv.x; o.y = v[j].y * rstd * gv.y; o.z = v[j].z * rstd * gv.z; o.w = v[j].w * rstd * gv.w; xr[lane + 64 * j] = o; }
}


#define LAS __attribute__((address_space(3)))
#define GAS __attribute__((address_space(1)))
typedef GAS unsigned gu32;
#define RLX_AGENT __ATOMIC_RELAXED, __HIP_MEMORY_SCOPE_AGENT
#define LDS_WAIT() asm volatile("s_waitcnt lgkmcnt(0)" ::: "memory")
#define VM_WAIT() asm volatile("s_waitcnt vmcnt(0)" ::: "memory")

#define XB_TMO      128
#define XB_XCNT(j)  (256  + 64 * (j))
#define XB_XSUB(j)  (1280 + 64 * (j))
#define XB_XGEN(j)  (2304 + 64 * (j))
#define XB_TOP      3328
#define XB_TOPGEN   3392
#define XCD_BAR_WORDS 3456
#define XB_SPIN_CAP (1u << 18)
__device__ __forceinline__ unsigned xb_ld(unsigned* p)              { return __hip_atomic_load(p, __ATOMIC_RELAXED, __HIP_MEMORY_SCOPE_AGENT); }
__device__ __forceinline__ unsigned xb_add(unsigned* p, unsigned v) { return __hip_atomic_fetch_add(p, v, __ATOMIC_RELAXED, __HIP_MEMORY_SCOPE_AGENT); }
__device__ __forceinline__ unsigned xb_xcc_id() { return (unsigned)__builtin_amdgcn_s_getreg((3 << 11) | 20) & 0xFu; }
#define XB_SPIN(cond, bar) do { unsigned _sp = 0; while (cond) { __builtin_amdgcn_s_sleep(1); \
    if ((++_sp & 255u) == 0u) { if (xb_ld(&(bar)[XB_TMO])) break; if (_sp > XB_SPIN_CAP) { atomicAdd(&(bar)[XB_TMO], 1u); break; } } } } while (0)
struct XcdBarrier { unsigned* bar; unsigned x; volatile LAS unsigned* st; };
__device__ __forceinline__ XcdBarrier xcd_barrier_post(unsigned* bar, volatile LAS unsigned* st) {
    XcdBarrier b; b.bar = bar; b.x = xb_xcc_id(); b.st = st;
    if (threadIdx.x == 0) (void)xb_add(&bar[XB_XCNT(b.x)], 1u);
    return b;
}
__device__ __forceinline__ void xcd_barrier_complete(unsigned* bar, unsigned x, unsigned& nloc, unsigned& nx) {
    const unsigned G = gridDim.x * gridDim.y * gridDim.z;
    unsigned sum, cnt, mine, sp = 0u;
    for (;;) {
        sum = 0u; cnt = 0u; mine = 0u;
#pragma unroll
        for (unsigned j = 0; j < 16; ++j) { const unsigned c = xb_ld(&bar[XB_XCNT(j)]); sum += c; cnt += (c > 0u) ? 1u : 0u; mine = (j == x) ? c : mine; }
        if (sum == G) break;
        __builtin_amdgcn_s_sleep(1);
        if ((++sp & 255u) == 0u) { if (xb_ld(&bar[XB_TMO])) break; if (sp > XB_SPIN_CAP) { atomicAdd(&bar[XB_TMO], 1u); break; } }
    }
    nloc = mine > 0u ? mine : 1u; nx = cnt > 0u ? cnt : 1u;
}
__device__ __forceinline__ void xcd_barrier(const XcdBarrier& b) {
    asm volatile("s_waitcnt vmcnt(0)" ::: "memory");
    __syncthreads();
    if (threadIdx.x == 0) {
        unsigned* bar = b.bar;
        __builtin_amdgcn_s_waitcnt(0);
        unsigned nloc = b.st[0], nx = b.st[1];
        if (nloc == 0u) { xcd_barrier_complete(bar, b.x, nloc, nx); b.st[0] = nloc; b.st[1] = nx; }
        const unsigned old = xb_add(&bar[XB_XSUB(b.x)], 1u);
        const unsigned gen = old / nloc;
        if (old + 1u == (gen + 1u) * nloc) {
            __builtin_amdgcn_fence(__ATOMIC_RELEASE, "agent");
            asm volatile("s_waitcnt vmcnt(0)" ::: "memory");
            const unsigned og = xb_add(&bar[XB_TOP], 1u);
            const unsigned tg = og / nx;
            if (og + 1u == (tg + 1u) * nx) xb_add(&bar[XB_TOPGEN], 1u);
            else XB_SPIN(xb_ld(&bar[XB_TOPGEN]) == tg, bar);
            __builtin_amdgcn_fence(__ATOMIC_ACQUIRE, "agent");
            xb_add(&bar[XB_XGEN(b.x)], 1u);
            asm volatile("s_waitcnt vmcnt(0)" ::: "memory");
        } else {
            XB_SPIN(xb_ld(&bar[XB_XGEN(b.x)]) == gen, bar);
            __builtin_amdgcn_fence(__ATOMIC_ACQUIRE, "agent");
            asm volatile("s_waitcnt vmcnt(0)" ::: "memory");
        }
    }
    __syncthreads();
}

constexpr int RING_OFF = 0, RING_BYTES = 131072;
constexpr int LDSCTL_OFF = RING_BYTES;
constexpr int CTAB_OFF = LDSCTL_OFF + 512;
constexpr int IDX_OFF = LDSCTL_OFF + 1024;
constexpr int LDS_BYTES = 147456;
constexpr int CW_BAR = 4096;

__device__ __forceinline__ unsigned cvt_pk_bf16(float lo, float hi) { unsigned r; asm volatile("v_cvt_pk_bf16_f32 %0, %1, %2" : "=v"(r) : "v"(lo), "v"(hi)); return r; }
__device__ __forceinline__ float fast_sigmoid(float x) { return __builtin_amdgcn_rcpf(1.f + __builtin_amdgcn_exp2f(-LOG2E * x)); }
__device__ __forceinline__ float fast_gelu(float x) {
    const float t = x * (-2.f * LOG2E * 0.7978845608028654f) * (1.f + 0.044715f * x * x);
    return x * __builtin_amdgcn_rcpf(1.f + __builtin_amdgcn_exp2f(t));
}

namespace pg8 {
constexpr int BM = 256, BK = 64, HALF = 128, HTB = HALF * BK * 2, STAGE_BYTES = 8 * HTB, NXCD = 8, WGM = 8;
__host__ __device__ __forceinline__ int lds_byte(int r, int c) { const int st = (r >> 4) * 2 + (c >> 5), rr = r & 15, cc = c & 31, ob = rr * 64 + cc * 2; return st * 1024 + (ob ^ (((ob >> 9) & 1) << 5)); }
__host__ __device__ __forceinline__ void stage_rc(int b, int& R, int& C) { const int st = b / 1024, sb = b % 1024, swz = sb ^ (((sb >> 9) & 1) << 5); R = (st >> 1) * 16 + swz / 64; C = (st & 1) * 32 + (swz % 64) / 2; }
__host__ __device__ __forceinline__ int perm32(int rho) { const int n = rho >> 4, i = rho & 15; return 8 * (i >> 2) + 4 * n + (i & 3); }

struct Unit { const char* A; const char* B0; const char* B1p; int pm, pn, aux, slot; };

struct TileOrder {
    int nM, nN, nwg, G, c;
    __device__ void init(int M, int N, int G_, int c_) { nM = M / BM; nN = N / BM; nwg = nM * nN; G = G_; c = c_; }
    __device__ bool tile(int i, int& pm, int& pn) const {
        const long L = (long)i * G + c; if (L >= nwg) return false;
        int wgid = (int)L; { const int q = nwg / NXCD, r = nwg % NXCD, xcd = wgid % NXCD, off = wgid / NXCD; wgid = (xcd < r ? xcd * (q + 1) : r * (q + 1) + (xcd - r) * q) + off; }
        const int nig = WGM * nN, gid = wgid / nig, fm = gid * WGM, gsz = (nM - fm) < WGM ? (nM - fm) : WGM;
        pm = fm + ((wgid % nig) % gsz); pn = (wgid % nig) / gsz; return true;
    }
};

template <class Epi, class Sched, bool GATHER>
__device__ __forceinline__ void gemm_phase(LAS unsigned char* lds, const int K, const int ldb, const Sched& S, const Epi& E, const LAS int* idx) {
    const int tid = threadIdx.x, wid = __builtin_amdgcn_readfirstlane(tid >> 6), lane = tid & 63, wr = wid >> 2, wc = wid & 3, fr = lane & 15, fq = lane >> 4;
    const int nt = K / BK, halfk = nt / 2;
    int RA[2], CA[2]; unsigned voffB[2];
#pragma unroll
    for (int i = 0; i < 2; ++i) { int R, C; stage_rc(tid * 16 + i * 8192, R, C); RA[i] = R; CA[i] = C; const int Rb = Epi::PERM ? ((R & ~31) + perm32(R & 31)) : R;
        voffB[i] = (unsigned)(Rb * ldb + C) * 2u; }
    const size_t kstep = (size_t)(BK * 2);
    const size_t hstepB = (size_t)HALF * ldb * 2;
    const unsigned ldsw = (unsigned)wid * 1024u;
    const int aoff = lds_byte(wr * 64 + fr, fq * 8), boff = lds_byte(wc * 32 + fr, fq * 8);
#define PG8_SA(b, h) (((b) * 2 + (h)) * HTB)
#define PG8_SB(b, h) ((4 + (b) * 2 + (h)) * HTB)
#define PG8_STAGE(bufoff, gbase, voff) do { _Pragma("unroll") for (int _i = 0; _i < 2; ++_i) \
        __builtin_amdgcn_global_load_lds((const unsigned*)((const char*)(gbase) + (voff)[_i]), (LAS unsigned*)(lds + (bufoff) + ldsw + _i * 8192), 16, 0, 0); } while (0)
#define PG8_LDA(dst, b, h) do { _Pragma("unroll") for (int m = 0; m < 4; ++m) _Pragma("unroll") for (int k = 0; k < 2; ++k) dst[m][k] = *(const LAS bf16x8*)(lds + PG8_SA(b, h) + aoff + m * 2048 + k * 1024); } while (0)
#define PG8_LDB(dst, b, h) do { _Pragma("unroll") for (int n = 0; n < 2; ++n) _Pragma("unroll") for (int k = 0; k < 2; ++k) dst[n][k] = *(const LAS bf16x8*)(lds + PG8_SB(b, h) + boff + n * 2048 + k * 1024); } while (0)
#define PG8_MMA(ai, bj, At, Bt) do { __builtin_amdgcn_s_setprio(1); _Pragma("unroll") for (int m = 0; m < 4; ++m) _Pragma("unroll") for (int n = 0; n < 2; ++n) _Pragma("unroll") for (int k = 0; k < 2; ++k) \
        acc[ai][bj][m][n] = __builtin_amdgcn_mfma_f32_16x16x32_bf16(Bt[n][k], At[m][k], acc[ai][bj][m][n], 0, 0, 0); __builtin_amdgcn_s_setprio(0); } while (0)
#define PG8_WAIT_V(n) asm volatile("s_waitcnt vmcnt(" #n ")" ::: "memory")
#define PG8_WAIT_L(n) asm volatile("s_waitcnt lgkmcnt(" #n ")" ::: "memory")
#define PG8_BAR __builtin_amdgcn_s_barrier()
#define PG8_SCHED __builtin_amdgcn_sched_barrier(0)
#define PG8_SETVA(va, slot_) do { _Pragma("unroll") for (int _h = 0; _h < 2; ++_h) _Pragma("unroll") for (int _i = 0; _i < 2; ++_i) { \
        if (GATHER) (va)[_h][_i] = (unsigned)(idx[(slot_) * 256 + _h * 128 + RA[_i]] & 0x7fffffff) * (unsigned)(K * 2) + (unsigned)(CA[_i] * 2); \
        else (va)[_h][_i] = (unsigned)((_h * 128 + RA[_i]) * K + CA[_i]) * 2u; } } while (0)
    Unit cur, nxt; int ui = 0;
    if (!S.next(0, cur)) return;
    f32x4 acc[2][2][4][2];
#pragma unroll
    for (int a = 0; a < 2; ++a)
#pragma unroll
        for (int b = 0; b < 2; ++b)
#pragma unroll
            for (int m = 0; m < 4; ++m)
#pragma unroll
                for (int n = 0; n < 2; ++n) acc[a][b][m][n] = (f32x4){0.f, 0.f, 0.f, 0.f};
    bf16x8 At[4][2], B0[2][2], B1[2][2];
    unsigned cva[2][2], nva[2][2];
    PG8_SETVA(cva, cur.slot);
    PG8_STAGE(PG8_SB(0, 0), cur.B0, voffB); PG8_STAGE(PG8_SB(0, 1), cur.B0 + hstepB, voffB); PG8_STAGE(PG8_SA(0, 0), cur.A, cva[0]); PG8_STAGE(PG8_SA(0, 1), cur.A, cva[1]);
    if (wr == 1) PG8_BAR;
    PG8_WAIT_V(2); PG8_BAR;
    PG8_STAGE(PG8_SB(1, 0), cur.B0 + kstep, voffB); PG8_STAGE(PG8_SA(1, 0), cur.A + kstep, cva[0]); PG8_STAGE(PG8_SB(1, 1), cur.B0 + hstepB + kstep, voffB);
    PG8_WAIT_V(6); PG8_BAR;
    for (;;) {
        const bool has_next = S.next(ui + 1, nxt);
        if (!has_next) { nxt.A = cur.A; nxt.B0 = cur.B0; nxt.B1p = cur.B1p; nxt.slot = cur.slot; }
        if (GATHER) { PG8_SETVA(nva, nxt.slot); }
        for (int t = 0; t < nt; t += 2) {
            const bool last = (t == nt - 2);
            const char* a1 = cur.A + (size_t)(t + 1) * kstep;
            const char* a2 = last ? nxt.A : cur.A + (size_t)(t + 2) * kstep;
            const char* b2 = last ? nxt.B0 : ((t + 2 < halfk) ? cur.B0 : cur.B1p) + (size_t)(t + 2) * kstep;
            const char* a3 = a2 + kstep; const char* b3 = b2 + kstep;
            unsigned v20[2], v21[2];
#pragma unroll
            for (int i = 0; i < 2; ++i) { v20[i] = (GATHER && last) ? nva[0][i] : cva[0][i]; v21[i] = (GATHER && last) ? nva[1][i] : cva[1][i]; }
            PG8_LDB(B0, 0, 0); PG8_LDB(B1, 0, 1); PG8_SCHED; PG8_LDA(At, 0, 0); PG8_STAGE(PG8_SA(1, 1), a1, cva[1]);
            PG8_WAIT_V(8); PG8_WAIT_L(0); PG8_BAR; PG8_MMA(0, 0, At, B0); PG8_MMA(0, 1, At, B1); PG8_BAR; PG8_SCHED;
            PG8_LDA(At, 0, 1); PG8_STAGE(PG8_SB(0, 0), b2, voffB); PG8_STAGE(PG8_SB(0, 1), b2 + hstepB, voffB); PG8_STAGE(PG8_SA(0, 0), a2, v20);
            PG8_WAIT_V(8); PG8_WAIT_L(0); PG8_BAR; PG8_MMA(1, 0, At, B0); PG8_MMA(1, 1, At, B1); PG8_BAR; PG8_SCHED;
            PG8_LDB(B0, 1, 0); PG8_LDB(B1, 1, 1); PG8_SCHED; PG8_LDA(At, 1, 0); PG8_STAGE(PG8_SA(0, 1), a2, v21);
            PG8_WAIT_V(8); PG8_WAIT_L(0); PG8_BAR; PG8_MMA(0, 0, At, B0); PG8_MMA(0, 1, At, B1); PG8_BAR; PG8_SCHED;
            PG8_LDA(At, 1, 1); PG8_STAGE(PG8_SB(1, 0), b3, voffB); PG8_STAGE(PG8_SB(1, 1), b3 + hstepB, voffB); PG8_STAGE(PG8_SA(1, 0), a3, v20);
            PG8_WAIT_V(8); PG8_WAIT_L(0); PG8_BAR; PG8_MMA(1, 0, At, B0); PG8_MMA(1, 1, At, B1); PG8_BAR; PG8_SCHED;
        }
        if (wr == 0) PG8_BAR;
        E(acc, cur, wr, wc, fr, fq);
        if (!has_next) break;
        if (!E.keep_acc(cur)) {
#pragma unroll
            for (int a = 0; a < 2; ++a)
#pragma unroll
                for (int b = 0; b < 2; ++b)
#pragma unroll
                    for (int m = 0; m < 4; ++m)
#pragma unroll
                        for (int n = 0; n < 2; ++n) acc[a][b][m][n] = (f32x4){0.f, 0.f, 0.f, 0.f};
        }
        cur = nxt; ++ui;
        if (GATHER) {
#pragma unroll
            for (int h = 0; h < 2; ++h)
#pragma unroll
                for (int i = 0; i < 2; ++i) cva[h][i] = nva[h][i];
        }
        if (wr == 1) PG8_BAR;
    }
    PG8_WAIT_V(0);
    PG8_BAR;
#undef PG8_SA
#undef PG8_SB
#undef PG8_STAGE
#undef PG8_LDA
#undef PG8_LDB
#undef PG8_MMA
#undef PG8_WAIT_V
#undef PG8_WAIT_L
#undef PG8_BAR
#undef PG8_SCHED
#undef PG8_SETVA
}
}

struct MkArgs {
    const float* in[20]; float* out; unsigned char* ws; int ph_lo, ph_hi, li, pad;
};
enum { PH_PRO = 0, PH_G1 = 1, PH_MIX = 2, PH_G3 = 3, PH_G4 = 4, PH_ROUTE = 5, PH_UP = 6, PH_DOWN = 7, PH_FINAL = 8, PH_N = 9 };

__device__ __forceinline__ unsigned pk2(float lo, float hi) { return (unsigned)f2bf(lo) | ((unsigned)f2bf(hi) << 16); }
__device__ __forceinline__ void p0_transpose_item(const float* W, int K, int N, bf16_t* WT, int row_off, int blk, int blk_stride, LAS float* scr, int item, int lane) {
    const int nblk = N / 32, kb = item / nblk, nb = item % nblk, k0 = 64 * kb, n0 = 32 * nb;
#pragma unroll 8
    for (int i = 0; i < 32; ++i) { const int kk = 2 * i + (lane >> 5); scr[kk * 33 + (lane & 31)] = W[(size_t)(k0 + kk) * N + n0 + (lane & 31)]; }
    LDS_WAIT(); asm volatile("" ::: "memory");
    const int c = lane & 7; const int rbase = row_off + (n0 / blk) * blk_stride + (n0 % blk);
#pragma unroll
    for (int j = 0; j < 4; ++j) { const int n = (lane >> 3) + 8 * j; const LAS float* s = scr + (8 * c) * 33 + n;
        u32x4 o; o.x = pk2(s[0 * 33], s[1 * 33]); o.y = pk2(s[2 * 33], s[3 * 33]); o.z = pk2(s[4 * 33], s[5 * 33]); o.w = pk2(s[6 * 33], s[7 * 33]);
        *(u32x4*)(WT + (size_t)(rbase + n) * K + k0 + 8 * c) = o; }
    LDS_WAIT(); asm volatile("" ::: "memory");
}
__device__ __forceinline__ void rms_row_to_bf16(const float* xrow, const float* g, bf16_t* orow, int lane) {
    const f32x4* xr = (const f32x4*)xrow;
    f32x4 v[4]; float s = 0.f;
#pragma unroll
    for (int j = 0; j < 4; ++j) { v[j] = xr[lane + 64 * j]; s += (v[j].x * v[j].x + v[j].y * v[j].y) + (v[j].z * v[j].z + v[j].w * v[j].w); }
    const float rstd = rsqrtf(wave_sum(s) * (1.f / D) + EPS);
#pragma unroll
    for (int j = 0; j < 4; ++j) { const f32x4 gv = ((const f32x4*)g)[lane + 64 * j];
        uint2 o; o.x = cvt_pk_bf16(v[j].x * rstd * gv.x, v[j].y * rstd * gv.y); o.y = cvt_pk_bf16(v[j].z * rstd * gv.z, v[j].w * rstd * gv.w);
        ((uint2*)orow)[lane + 64 * j] = o; }
}

typedef float f32x2 __attribute__((ext_vector_type(2)));
struct EpiG1 {
    static constexpr bool PERM = true;
    bf16_t *U, *V, *Q, *Kb, *VV, *GA, *GB; float* vstat;
    __device__ __forceinline__ bool keep_acc(const pg8::Unit&) const { return false; }
    __device__ __forceinline__ void operator()(f32x4 (&acc)[2][2][4][2], const pg8::Unit& u, int wr, int wc, int fr, int fq) const {
        const int pn = u.pn, row0 = u.pm * 256 + wr * 64 + fr, cw = wc * 32 + 8 * fq;
        int act, ldc; bf16_t* d0; bf16_t* d1;
        if (pn < 2) { act = 1; ldc = 512; d0 = U + pn * 256 + cw; d1 = d0 + 128; }
        else if (pn < 4) { act = 2; ldc = 512; d0 = V + (pn - 2) * 256 + cw; d1 = d0 + 128; }
        else if (pn < 6) { act = 3; ldc = 512; d0 = Q + (pn - 4) * 256 + cw; d1 = d0 + 128; }
        else if (pn == 6) { act = 0; ldc = 128; d0 = Kb + cw; d1 = VV + cw; }
        else if (pn < 11) { act = 4; ldc = 1024; d0 = GA + (pn - 7) * 256 + cw; d1 = d0 + 128; }
        else { act = 4; ldc = 1024; d0 = GB + (pn - 11) * 256 + cw; d1 = d0 + 128; }
#pragma unroll
        for (int ai = 0; ai < 2; ++ai)
#pragma unroll
            for (int m = 0; m < 4; ++m) {
                const int row = row0 + ai * 128 + m * 16; float s = 0.f, q = 0.f;
#pragma unroll
                for (int bj = 0; bj < 2; ++bj) {
                    f32x4 v0 = acc[ai][bj][m][0], v1 = acc[ai][bj][m][1];
                    if (act == 1 || act == 2) {
#pragma unroll
                        for (int e = 0; e < 4; ++e) { v0[e] = fast_gelu(v0[e]); v1[e] = fast_gelu(v1[e]); }
                        if (act == 2) {
#pragma unroll
                            for (int e = 0; e < 4; ++e) { s += v0[e] + v1[e]; q += v0[e] * v0[e] + v1[e] * v1[e]; }
                        }
                    } else if (act == 3) { v0 = v0 * (0.125f * LOG2E); v1 = v1 * (0.125f * LOG2E); }
                    else if (act == 4) {
#pragma unroll
                        for (int e = 0; e < 4; ++e) { v0[e] = fast_sigmoid(v0[e]); v1[e] = fast_sigmoid(v1[e]); }
                    }
                    u32x4 w; w.x = cvt_pk_bf16(v0[0], v0[1]); w.y = cvt_pk_bf16(v0[2], v0[3]); w.z = cvt_pk_bf16(v1[0], v1[1]); w.w = cvt_pk_bf16(v1[2], v1[3]);
                    *(u32x4*)((bj ? d1 : d0) + (size_t)row * ldc) = w;
                }
                if (act == 2) {
                    s += __shfl_xor(s, 16); s += __shfl_xor(s, 32); q += __shfl_xor(q, 16); q += __shfl_xor(q, 32);
                    if (fq == 0) *(f32x2*)(vstat + (size_t)row * 16 + ((pn - 2) * 4 + wc) * 2) = (f32x2){s, q};
                }
            }
    }
};
struct SchedG1 {
    pg8::TileOrder o; const char* A; const char* B;
    __device__ __forceinline__ bool next(int i, pg8::Unit& u) const { int pm, pn; if (!o.tile(i, pm, pn)) return false;
        u.A = A + (size_t)pm * 256 * D * 2; u.B0 = B + (size_t)pn * 256 * D * 2; u.B1p = u.B0; u.pm = pm; u.pn = pn; u.aux = 0; u.slot = 0; return true; }
};
struct EpiG3 {
    static constexpr bool PERM = true;
    const bf16_t *GA, *GB; bf16_t* M;
    __device__ __forceinline__ bool keep_acc(const pg8::Unit& u) const { return u.aux == 0; }
    __device__ __forceinline__ void operator()(f32x4 (&acc)[2][2][4][2], const pg8::Unit& u, int wr, int wc, int fr, int fq) const {
        const int row0 = u.pm * 256 + wr * 64 + fr, col0 = u.pn * 256 + wc * 32 + 8 * fq;
#pragma unroll
        for (int ai = 0; ai < 2; ++ai)
#pragma unroll
            for (int m = 0; m < 4; ++m)
#pragma unroll
                for (int bj = 0; bj < 2; ++bj) {
                    const size_t off = (size_t)(row0 + ai * 128 + m * 16) * D + col0 + bj * 128;
                    const u32x4 gb = *(const u32x4*)(GB + off);
                    float b[8];
#pragma unroll
                    for (int e = 0; e < 4; ++e) { b[2 * e] = __uint_as_float(gb[e] << 16); b[2 * e + 1] = __uint_as_float(gb[e] & 0xffff0000u); }
                    if (u.aux == 0) {
                        const u32x4 ga = *(const u32x4*)(GA + off);
#pragma unroll
                        for (int e = 0; e < 4; ++e) { const float a0 = __uint_as_float(ga[e] << 16), a1 = __uint_as_float(ga[e] & 0xffff0000u);
                            const float r0 = a0 * __builtin_amdgcn_rcpf(fmaxf(b[2 * e], 1e-30f)), r1 = a1 * __builtin_amdgcn_rcpf(fmaxf(b[2 * e + 1], 1e-30f));
                            const int n = e >> 1, k = (e & 1) * 2; acc[ai][bj][m][n][k] *= r0; acc[ai][bj][m][n][k + 1] *= r1; }
                    } else {
                        const f32x4 v0 = acc[ai][bj][m][0], v1 = acc[ai][bj][m][1];
                        u32x4 w; w.x = cvt_pk_bf16(v0[0] * b[0], v0[1] * b[1]); w.y = cvt_pk_bf16(v0[2] * b[2], v0[3] * b[3]);
                        w.z = cvt_pk_bf16(v1[0] * b[4], v1[1] * b[5]); w.w = cvt_pk_bf16(v1[2] * b[6], v1[3] * b[7]);
                        *(u32x4*)(M + off) = w;
                    }
                }
    }
};
struct SchedG3 {
    pg8::TileOrder o; const char *A, *B, *WA, *WB;
    __device__ __forceinline__ bool next(int j, pg8::Unit& u) const { int pm, pn; if (!o.tile(j >> 1, pm, pn)) return false; const int w = j & 1;
        u.A = (w ? B : A) + (size_t)pm * 256 * 512 * 2; u.B0 = (w ? WB : WA) + (size_t)pn * 256 * 512 * 2; u.B1p = u.B0; u.pm = pm; u.pn = pn; u.aux = w; u.slot = 0; return true; }
};
struct EpiG4 {
    static constexpr bool PERM = false;
    const float* x; float* H;
    __device__ __forceinline__ bool keep_acc(const pg8::Unit&) const { return false; }
    __device__ __forceinline__ void operator()(f32x4 (&acc)[2][2][4][2], const pg8::Unit& u, int wr, int wc, int fr, int fq) const {
        const int row0 = u.pm * 256 + wr * 64 + fr, col0 = u.pn * 256 + wc * 32 + 4 * fq;
#pragma unroll
        for (int ai = 0; ai < 2; ++ai)
#pragma unroll
            for (int m = 0; m < 4; ++m)
#pragma unroll
                for (int bj = 0; bj < 2; ++bj)
#pragma unroll
                    for (int n = 0; n < 2; ++n) { const size_t off = (size_t)(row0 + ai * 128 + m * 16) * D + col0 + bj * 128 + n * 16;
                        *(f32x4*)(H + off) = *(const f32x4*)(x + off) + acc[ai][bj][m][n]; }
    }
};
struct SchedG4 {
    pg8::TileOrder o; const char* A; const char* B;
    __device__ __forceinline__ bool next(int i, pg8::Unit& u) const { int pm, pn; if (!o.tile(i, pm, pn)) return false;
        u.A = A + (size_t)pm * 256 * D * 2; u.B0 = B + (size_t)pn * 256 * D * 2; u.B1p = u.B0; u.pm = pm; u.pn = pn; u.aux = 0; u.slot = 0; return true; }
};
__device__ __forceinline__ int class_of_tile(const LAS int* ctab, int mt) { int cls = 0;
#pragma unroll 1
    for (int c = 0; c < NCLS; ++c) if (mt * 256 >= ctab[c + 1]) cls = c + 1;
    return cls; }
struct SchedUp {
    const LAS int* ctab; const char* A; const char* W; int G, c;
    __device__ __forceinline__ bool next(int i, pg8::Unit& u) const { const int L = i * G + c, NU = (ctab[NCLS] >> 8) * 8; if (L >= NU) return false;
        const int mt = L >> 3, j = L & 7, cls = class_of_tile(ctab, mt); int e1, e2; class_experts(cls, e1, e2); const int e = j < 4 ? e1 : e2;
        u.A = A; u.B0 = W + ((size_t)e * 1024 + (j & 3) * 256) * D * 2; u.B1p = u.B0; u.pm = mt; u.pn = j; u.aux = cls; u.slot = i; return true; }
};
struct EpiUp {
    static constexpr bool PERM = true;
    const LAS int* ctab; const float* wl; bf16_t* HID;
    __device__ __forceinline__ bool keep_acc(const pg8::Unit&) const { return false; }
    __device__ __forceinline__ void operator()(f32x4 (&acc)[2][2][4][2], const pg8::Unit& u, int wr, int wc, int fr, int fq) const {
        const int cls = u.aux, sel = u.pn >> 2, rank0 = u.pm * 256 - ctab[cls], cnt = ctab[32 + cls];
        const int col0 = sel * 512 + (u.pn & 3) * 128 + wc * 32 + 8 * fq;
#pragma unroll
        for (int ai = 0; ai < 2; ++ai)
#pragma unroll
            for (int m = 0; m < 4; ++m) {
                const int R = ai * 128 + wr * 64 + m * 16 + fr, rank = rank0 + R;
                const float w = rank < cnt ? wl[((size_t)cls * T + rank) * 2 + sel] : 0.f;
                const f32x4 g0 = acc[ai][0][m][0], g1 = acc[ai][0][m][1], u0 = acc[ai][1][m][0], u1 = acc[ai][1][m][1];
                float h[8];
#pragma unroll
                for (int e = 0; e < 4; ++e) { h[e] = w * g0[e] * fast_sigmoid(g0[e]) * u0[e]; h[4 + e] = w * g1[e] * fast_sigmoid(g1[e]) * u1[e]; }
                u32x4 o; o.x = cvt_pk_bf16(h[0], h[1]); o.y = cvt_pk_bf16(h[2], h[3]); o.z = cvt_pk_bf16(h[4], h[5]); o.w = cvt_pk_bf16(h[6], h[7]);
                *(u32x4*)(HID + ((size_t)u.pm * 256 + R) * 1024 + col0) = o;
            }
    }
};
struct SchedDown {
    const LAS int* ctab; const char* A; const char* W; int G, c;
    __device__ __forceinline__ bool next(int i, pg8::Unit& u) const { const int L = i * G + c, NU = (ctab[NCLS] >> 8) * 4; if (L >= NU) return false;
        const int mt = L >> 2, j = L & 3, cls = class_of_tile(ctab, mt); int e1, e2; class_experts(cls, e1, e2);
        u.A = A + (size_t)mt * 256 * 1024 * 2; u.B0 = W + ((size_t)e1 * 1024 + j * 256) * 512 * 2; u.B1p = W + ((size_t)e2 * 1024 + j * 256) * 512 * 2 - 8 * 128;
        u.pm = mt; u.pn = j; u.aux = cls; u.slot = i; return true; }
};
struct EpiDown {
    static constexpr bool PERM = false;
    const LAS int* idx; const float* H; float* OUT;
    __device__ __forceinline__ bool keep_acc(const pg8::Unit&) const { return false; }
    __device__ __forceinline__ void operator()(f32x4 (&acc)[2][2][4][2], const pg8::Unit& u, int wr, int wc, int fr, int fq) const {
        const int col0 = u.pn * 256 + wc * 32 + 4 * fq;
#pragma unroll
        for (int ai = 0; ai < 2; ++ai)
#pragma unroll
            for (int m = 0; m < 4; ++m) {
                const int tok = idx[u.slot * 256 + ai * 128 + wr * 64 + m * 16 + fr];
                if (tok >= 0) {
#pragma unroll
                    for (int bj = 0; bj < 2; ++bj)
#pragma unroll
                        for (int n = 0; n < 2; ++n) { const size_t off = (size_t)tok * D + col0 + bj * 128 + n * 16;
                            *(f32x4*)(OUT + off) = *(const f32x4*)(H + off) + acc[ai][bj][m][n]; }
                }
            }
    }
};
template <int NTN>
__device__ __forceinline__ void fill_idx(LAS int* idx, const LAS int* ctab, const int* list, int G, int c) {
    const int NU = (ctab[NCLS] >> 8) * NTN;
    for (int i = 0; i < 8; ++i) { const int L = i * G + c; if (L >= NU) break;
        const int mt = L / NTN, cls = class_of_tile(ctab, mt);
        if (threadIdx.x < 256) { const int rank = mt * 256 + (int)threadIdx.x - ctab[cls], cnt = ctab[32 + cls];
            idx[i * 256 + threadIdx.x] = rank < cnt ? list[(size_t)cls * T + rank] : (list[(size_t)cls * T] | (int)0x80000000); } }
    __syncthreads();
}

__global__ void __launch_bounds__(512, 2) mk_fwd(MkArgs args) {
    extern __shared__ __attribute__((aligned(16))) unsigned char lds_raw[];
    LAS unsigned char* lds = (LAS unsigned char*)lds_raw;
    volatile LAS unsigned* MISC = (volatile LAS unsigned*)(lds + LDSCTL_OFF);
    LAS int* ctab = (LAS int*)(lds + CTAB_OFF);
    LAS int* idx = (LAS int*)(lds + IDX_OFF);
    const int tid = threadIdx.x, lane = tid & 63, wave = __builtin_amdgcn_readfirstlane(tid >> 6);
    const int G = gridDim.x, bx = blockIdx.x; const int vcu = (G % 8 == 0) ? (bx % 8) * (G / 8) + bx / 8 : bx;
    unsigned char* ws = args.ws;
    unsigned* ctl = (unsigned*)(ws + WS_CTL);
    const float* x = args.in[0];
    bf16_t* WIN = (bf16_t*)(ws + WS_WIN); bf16_t* WPA = (bf16_t*)(ws + WS_WPA); bf16_t* WPB = (bf16_t*)(ws + WS_WPB); bf16_t* WOUT = (bf16_t*)(ws + WS_WOUT);
    bf16_t* WUP = (bf16_t*)(ws + WS_WUP); bf16_t* WDN = (bf16_t*)(ws + WS_WDN); bf16_t* WSB = (bf16_t*)(ws + WS_WSB); float* BIAS = (float*)(ws + WS_BIAS);
    bf16_t* HN = (bf16_t*)(ws + WS_HN); bf16_t* U = (bf16_t*)(ws + WS_U); bf16_t* V = (bf16_t*)(ws + WS_V); bf16_t* Q = (bf16_t*)(ws + WS_Q); bf16_t* Kb = (bf16_t*)(ws + WS_K);
    bf16_t* VV = (bf16_t*)(ws + WS_VV); bf16_t* GA = (bf16_t*)(ws + WS_GA); bf16_t* GB = (bf16_t*)(ws + WS_GB); bf16_t* A = (bf16_t*)(ws + WS_A); bf16_t* B = (bf16_t*)(ws + WS_B);
    float* H = (float*)(ws + WS_H); bf16_t* HID = (bf16_t*)(ws + WS_HID); float* VSTAT = (float*)(ws + WS_VSTAT); int* LIST = (int*)(ws + WS_LIST); float* WL = (float*)(ws + WS_WL);
    bf16_t* MERGED = HN; bf16_t* HN2 = HN;

    for (int u = tid; u < 128; u += 512) MISC[u] = 0u;
    __syncthreads();
    XcdBarrier bar = xcd_barrier_post(ctl + CW_BAR + args.li * XCD_BAR_WORDS, MISC + 8);
    const int lo = args.ph_lo, hi = args.ph_hi;
#define IN(k) (lo <= (k) && (k) < hi)
#define SEAM(k) do { if (IN(k) && IN((k) + 1)) xcd_barrier(bar); } while (0)

    if (IN(PH_PRO)) {
        LAS float* scr = (LAS float*)(lds + RING_OFF + wave * 16384);
        const int gw = vcu * 8 + wave, NGW = G * 8;
        constexpr int I_IN = (D / 64) * (NIN / 32), I_P = (512 / 64) * (D / 32), I_O = (D / 64) * (D / 32), I_G = (D / 64) * (FF / 32), I_D = (FF / 64) * (D / 32);
        constexpr int NITEMS = I_IN + 2 * I_P + I_O + NEXP * (2 * I_G + I_D);
        for (int it = gw; it < NITEMS; it += NGW) {
            int r = it;
            if (r < I_IN) { p0_transpose_item(args.in[2], D, NIN, WIN, 0, NIN, NIN, scr, r, lane); continue; } r -= I_IN;
            if (r < I_P) { p0_transpose_item(args.in[8], 512, D, WPA, 0, D, D, scr, r, lane); continue; } r -= I_P;
            if (r < I_P) { p0_transpose_item(args.in[9], 512, D, WPB, 0, D, D, scr, r, lane); continue; } r -= I_P;
            if (r < I_O) { p0_transpose_item(args.in[10], D, D, WOUT, 0, D, D, scr, r, lane); continue; } r -= I_O;
            const int e = r / (2 * I_G + I_D); r -= e * (2 * I_G + I_D);
            if (r < I_G) { p0_transpose_item(args.in[16] + (size_t)e * D * FF, D, FF, WUP + (size_t)e * 1024 * D, 0, 128, 256, scr, r, lane); continue; } r -= I_G;
            if (r < I_G) { p0_transpose_item(args.in[17] + (size_t)e * D * FF, D, FF, WUP + (size_t)e * 1024 * D, 128, 128, 256, scr, r, lane); continue; } r -= I_G;
            p0_transpose_item(args.in[18] + (size_t)e * FF * D, FF, D, WDN + (size_t)e * 1024 * FF, 0, D, D, scr, r, lane);
        }
        for (int i = (vcu * 512 + tid); i < 8 * 128 * 128; i += G * 512) { const int s = i & 127, t = (i >> 7) & 127; WSB[i] = (s <= t) ? f2bf(args.in[4][i]) : (bf16_t)0; }
        for (int i = (vcu * 512 + tid); i < 8 * 128; i += G * 512) { const int h = i >> 7, dist = i & 127; BIAS[i] = args.in[7][kBucket[dist] * 8 + h] * LOG2E; }
        for (int m = gw; m < T; m += NGW) rms_row_to_bf16(x + (size_t)m * D, args.in[1], HN + (size_t)m * D, lane);
    }
    SEAM(PH_PRO);
    if (IN(PH_G1)) {
        SchedG1 S; S.o.init(T, NIN, G, bx); S.A = (const char*)HN; S.B = (const char*)WIN;
        EpiG1 E{U, V, Q, Kb, VV, GA, GB, VSTAT};
        pg8::gemm_phase<EpiG1, SchedG1, false>(lds + RING_OFF, D, D, S, E, idx);
    }
    SEAM(PH_G1);
    if (IN(PH_MIX)) {
        const int gw = vcu * 8 + wave, NGW = G * 8;
        LAS float* vn = (LAS float*)(lds + RING_OFF);
        LAS float* st = (LAS float*)(lds + RING_OFF + 32768);
        for (int chunk = bx; chunk < T / 128; chunk += G) {
            if (tid < 128) { const int row = chunk * 128 + tid; float s = 0.f, q = 0.f;
                for (int p = 0; p < 8; ++p) { s += VSTAT[(size_t)row * 16 + 2 * p]; q += VSTAT[(size_t)row * 16 + 2 * p + 1]; }
                const float mean = s * (1.f / 512.f), var = fmaxf(q * (1.f / 512.f) - mean * mean, 0.f); st[tid * 2] = mean; st[tid * 2 + 1] = rsqrtf(var + EPS); }
            __syncthreads();
            for (int g = 0; g < 8; ++g) {
                { const int s = tid >> 2, d0 = (tid & 3) * 16; const float mean = st[s * 2], rstd = st[s * 2 + 1];
                  const bf16_t* src = V + (size_t)(chunk * 128 + s) * 512 + g * 64 + d0;
                  for (int e = 0; e < 16; ++e) vn[s * 64 + d0 + e] = (bf2f(src[e]) - mean) * rstd * args.in[3][g * 64 + d0 + e]; }
                __syncthreads();
                { const int d = tid & 63;
                  for (int k = 0; k < 16; ++k) { const int t = k * 8 + wave; float acc = 0.f; const bf16_t* wrow = WSB + (size_t)(g * 128 + t) * 128;
                      for (int s = 0; s <= t; ++s) acc += bf2f(wrow[s]) * vn[s * 64 + d];
                      const size_t o = (size_t)(chunk * 128 + t) * 512 + g * 64 + d;
                      A[o] = f2bf(bf2f(U[o]) * (acc + args.in[5][g * 128 + t])); } }
                __syncthreads();
            }
        }
        for (int w = gw; w < T * 8; w += NGW) {
            const int t = w >> 3, h = w & 7, kh = h >> 2, pos = t & (SEQ - 1), bb = t - pos;
            float sc[2]; float m = args.in[6][h] * LOG2E; const float sink2 = m;
#pragma unroll
            for (int u2 = 0; u2 < 2; ++u2) {
                const int j = lane + 64 * u2, kpos = pos - 127 + j, dist = 127 - j;
                float s = -1e30f;
                if (kpos >= 0) { float a = 0.f; const bf16_t* qp = Q + (size_t)t * 512 + h * 64; const bf16_t* kp = Kb + (size_t)(bb + kpos) * 128 + kh * 64;
                    for (int d = 0; d < 64; ++d) a += bf2f(qp[d]) * bf2f(kp[d]);
                    s = a + BIAS[h * 128 + dist]; }
                sc[u2] = s; m = fmaxf(m, s);
            }
            m = wave_max(m);
            float p0 = exp2f(sc[0] - m), p1 = exp2f(sc[1] - m);
            const float denom = wave_sum(p0 + p1) + exp2f(sink2 - m);
            p0 /= denom; p1 /= denom;
            float o = 0.f;
            for (int j = 0; j < 128; ++j) { const float p = __shfl(j < 64 ? p0 : p1, j & 63); const int kpos = pos - 127 + j;
                if (kpos >= 0) o += p * bf2f(VV[(size_t)(bb + kpos) * 128 + kh * 64 + lane]); }
            B[(size_t)t * 512 + h * 64 + lane] = f2bf(o);
        }
    }
    SEAM(PH_MIX);
    if (IN(PH_G3)) {
        SchedG3 S; S.o.init(T, D, G, bx); S.A = (const char*)A; S.B = (const char*)B; S.WA = (const char*)WPA; S.WB = (const char*)WPB;
        EpiG3 E{GA, GB, MERGED};
        pg8::gemm_phase<EpiG3, SchedG3, false>(lds + RING_OFF, 512, 512, S, E, idx);
    }
    SEAM(PH_G3);
    if (IN(PH_G4)) {
        SchedG4 S; S.o.init(T, D, G, bx); S.A = (const char*)MERGED; S.B = (const char*)WOUT;
        EpiG4 E{x, H};
        pg8::gemm_phase<EpiG4, SchedG4, false>(lds + RING_OFF, D, D, S, E, idx);
    }
    SEAM(PH_G4);
    if (IN(PH_ROUTE)) {
        LAS int* rcls = (LAS int*)(lds + RING_OFF); LAS float* rwa = (LAS float*)(lds + RING_OFF + 512); LAS float* rwb = (LAS float*)(lds + RING_OFF + 1024); LAS int* rbase = (LAS int*)(lds + RING_OFF + 1536);
        const float* g2 = args.in[11]; const float* rgw = args.in[12]; const float* rgb = args.in[13]; const float* rew = args.in[14]; const float* reb = args.in[15];
        for (int chunk = bx; chunk < T / 128; chunk += G) {
            for (int k = 0; k < 16; ++k) {
                const int tl = wave * 16 + k, row = chunk * 128 + tl;
                const f32x4* xr = (const f32x4*)(H + (size_t)row * D);
                f32x4 v[4]; float s = 0.f;
#pragma unroll
                for (int j = 0; j < 4; ++j) { v[j] = xr[lane + 64 * j]; s += (v[j].x * v[j].x + v[j].y * v[j].y) + (v[j].z * v[j].z + v[j].w * v[j].w); }
                const float rstd = rsqrtf(wave_sum(s) * (1.f / D) + EPS);
                float lg[20];
#pragma unroll
                for (int o = 0; o < 20; ++o) lg[o] = 0.f;
#pragma unroll
                for (int j = 0; j < 4; ++j) { const f32x4 gv = ((const f32x4*)g2)[lane + 64 * j];
                    const f32x4 n = v[j] * rstd * gv;
                    uint2 o; o.x = cvt_pk_bf16(n.x, n.y); o.y = cvt_pk_bf16(n.z, n.w);
                    ((uint2*)(HN2 + (size_t)row * D))[lane + 64 * j] = o;
#pragma unroll
                    for (int e = 0; e < 4; ++e) { const int c = 4 * (lane + 64 * j) + e; const float hv = n[e];
                        const f32x4 wg = *(const f32x4*)(rgw + (size_t)c * 4);
                        lg[0] += hv * wg.x; lg[1] += hv * wg.y; lg[2] += hv * wg.z; lg[3] += hv * wg.w;
#pragma unroll
                        for (int g = 0; g < 4; ++g) { const f32x4 we = *(const f32x4*)(rew + ((size_t)g * D + c) * 4);
                            lg[4 + g * 4 + 0] += hv * we.x; lg[4 + g * 4 + 1] += hv * we.y; lg[4 + g * 4 + 2] += hv * we.z; lg[4 + g * 4 + 3] += hv * we.w; } } }
#pragma unroll
                for (int o = 0; o < 20; ++o) lg[o] = wave_sum(lg[o]);
                if (lane == 0) { int cls; float wa, wb; route_token(lg, rgb, reb, cls, wa, wb); rcls[tl] = cls; rwa[tl] = wa; rwb[tl] = wb; }
            }
            __syncthreads();
            if (tid < NCLS) { int n = 0; for (int i = 0; i < 128; ++i) n += (rcls[i] == tid) ? 1 : 0; rbase[tid] = n ? (int)atomicAdd(ctl + CW_CNT + 16 * tid, (unsigned)n) : 0; }
            __syncthreads();
            if (tid < 128) { const int cls = rcls[tid]; int lr = 0; for (int i = 0; i < tid; ++i) lr += (rcls[i] == cls) ? 1 : 0; const int rank = rbase[cls] + lr;
                LIST[(size_t)cls * T + rank] = chunk * 128 + tid; WL[((size_t)cls * T + rank) * 2] = rwa[tid]; WL[((size_t)cls * T + rank) * 2 + 1] = rwb[tid]; }
            __syncthreads();
        }
    }
    SEAM(PH_ROUTE);
    if (IN(PH_UP) || IN(PH_DOWN)) {
        if (tid == 0) { int off = 0; for (int c = 0; c < NCLS; ++c) { const int n = (int)ctl[CW_CNT + 16 * c]; ctab[c] = off; ctab[32 + c] = n; off += (n + 255) & ~255; } ctab[NCLS] = off; }
        __syncthreads();
    }
    if (IN(PH_UP)) {
        fill_idx<8>(idx, ctab, LIST, G, bx);
        SchedUp S{ctab, (const char*)HN2, (const char*)WUP, G, bx};
        EpiUp E{ctab, WL, HID};
        pg8::gemm_phase<EpiUp, SchedUp, true>(lds + RING_OFF, D, D, S, E, idx);
    }
    SEAM(PH_UP);
    if (IN(PH_DOWN)) {
        fill_idx<4>(idx, ctab, LIST, G, bx);
        SchedDown S{ctab, (const char*)HID, (const char*)WDN, G, bx};
        EpiDown E{idx, H, args.out};
        pg8::gemm_phase<EpiDown, SchedDown, false>(lds + RING_OFF, D, 512, S, E, idx);
    }
    SEAM(PH_DOWN);
    if (IN(PH_FINAL)) {
        const int gw = vcu * 8 + wave, NGW = G * 8;
        for (int m = gw; m < T; m += NGW) { f32x4* xr = (f32x4*)(args.out + (size_t)m * D); f32x4 v[4]; float s = 0.f;
#pragma unroll
            for (int j = 0; j < 4; ++j) { v[j] = xr[lane + 64 * j]; s += (v[j].x * v[j].x + v[j].y * v[j].y) + (v[j].z * v[j].z + v[j].w * v[j].w); }
            const float rstd = rsqrtf(wave_sum(s) * (1.f / D) + EPS);
#pragma unroll
            for (int j = 0; j < 4; ++j) { const f32x4 gv = ((const f32x4*)args.in[19])[lane + 64 * j]; xr[lane + 64 * j] = v[j] * rstd * gv; } }
    }
#undef IN
#undef SEAM
}
static int mk_grid() {
    static int grid = 0;
    if (grid == 0) {
        int dev = 0, cus = 0, per_cu = 0;
        if (hipGetDevice(&dev) != hipSuccess || hipDeviceGetAttribute(&cus, hipDeviceAttributeMultiprocessorCount, dev) != hipSuccess) { grid = -1; return grid; }
        if (hipFuncSetAttribute((const void*)mk_fwd, hipFuncAttributeMaxDynamicSharedMemorySize, LDS_BYTES) != hipSuccess) { fprintf(stderr, "kernel_launch: hipFuncSetAttribute failed\n"); grid = -1; return grid; }
        if (hipOccupancyMaxActiveBlocksPerMultiprocessor(&per_cu, (const void*)mk_fwd, 512, LDS_BYTES) != hipSuccess || per_cu < 1) { fprintf(stderr, "kernel_launch: occupancy query says %d\n", per_cu); }
        (void)hipGetLastError();
        grid = cus;
    }
    return grid;
}
extern "C" void kernel_launch(void* const* d_in, const int* in_sizes, int n_in, void* d_out, int out_size, void* d_ws, size_t ws_size, hipStream_t stream) {
    if (n_in != 20 || out_size != T * D || ws_size < WS_END) { fprintf(stderr, "kernel_launch: unexpected shapes (n_in %d out %d ws %zu)\n", n_in, out_size, ws_size); return; }
    const int grid = mk_grid(); if (grid <= 0) return;
    unsigned char* ws = (unsigned char*)d_ws;
    (void)hipMemsetAsync(ws + WS_CTL, 0, CTL_BYTES, stream);
    MkArgs a{}; for (int i = 0; i < 20; ++i) a.in[i] = (const float*)d_in[i]; a.out = (float*)d_out; a.ws = ws;
    a.ph_lo = PH_PRO; a.ph_hi = PH_N; a.li = 0; hipLaunchKernelGGL(mk_fwd, dim3(grid), dim3(512), LDS_BYTES, stream, a);
}
```

```cpp
#include <hip/hip_runtime.h>
#include <stdint.h>
#include <stdio.h>

typedef unsigned short bf16_t;
typedef short bf16x8 __attribute__((ext_vector_type(8)));
typedef float f32x4 __attribute__((ext_vector_type(4)));
typedef unsigned u32x4 __attribute__((ext_vector_type(4)));

constexpr int T = 32768, D = 1024, SEQ = 4096, NIN = 3840;
constexpr int GMW = 512, AW = 512, KVW = 128, FF = 512, NEXP = 16, NCLS = 24;
constexpr float EPS = 1e-6f;
constexpr float LOG2E = 1.4426950408889634f;

constexpr size_t MiB = 1u << 20;
constexpr size_t WS_CTL = 0, CTL_BYTES = 1 * MiB;
constexpr size_t WS_WIN = 1 * MiB;
constexpr size_t WS_WPA = 9 * MiB;
constexpr size_t WS_WPB = 10 * MiB;
constexpr size_t WS_WOUT = 11 * MiB;
constexpr size_t WS_WUP = 13 * MiB;
constexpr size_t WS_WDN = 45 * MiB;
constexpr size_t WS_WSB = 61 * MiB;
constexpr size_t WS_BIAS = 62 * MiB;
constexpr size_t WS_HN = 64 * MiB;
constexpr size_t WS_U = 128 * MiB, WS_V = 160 * MiB, WS_Q = 192 * MiB, WS_K = 224 * MiB, WS_VV = 232 * MiB;
constexpr size_t WS_GA = 240 * MiB, WS_GB = 304 * MiB;
constexpr size_t WS_A = 368 * MiB, WS_B = 400 * MiB;
constexpr size_t WS_H = 128 * MiB;
constexpr size_t WS_HID = 256 * MiB;
constexpr size_t WS_VSTAT = 432 * MiB;
constexpr size_t WS_LIST = 434 * MiB;
constexpr size_t WS_WL = 437 * MiB;
constexpr size_t WS_VN = 445 * MiB;
constexpr size_t WS_END = 509 * MiB;
constexpr int CW_CNT = 64;
constexpr int CW_OFF = 1024;

__device__ __forceinline__ float bf2f(bf16_t v) { return __uint_as_float((unsigned)v << 16); }
__device__ __forceinline__ bf16_t f2bf(float f) { unsigned u = __float_as_uint(f); return (bf16_t)((u + 0x7fffu + ((u >> 16) & 1u)) >> 16); }
__device__ __forceinline__ float wave_sum(float v) {
#pragma unroll
    for (int o = 1; o < 64; o <<= 1) v += __shfl_xor(v, o);
    return v;
}
__device__ __forceinline__ float wave_max(float v) {
#pragma unroll
    for (int o = 1; o < 64; o <<= 1) v = fmaxf(v, __shfl_xor(v, o));
    return v;
}
__device__ __forceinline__ float gelu_tanh(float x) {
    const float u = 0.7978845608028654f * (x + 0.044715f * x * x * x);
    const float e = __expf(2.f * u);
    const float th = 1.f - 2.f / (1.f + e);
    return 0.5f * x * (1.f + th);
}
__device__ __forceinline__ float sigmoidf_(float x) { return 1.f / (1.f + __expf(-x)); }

__device__ const unsigned char kBucket[128] = {
    0, 1, 2, 3, 4, 5, 6, 7, 8, 9, 10, 11, 12, 13, 14, 15, 16, 16, 16, 17, 17, 18, 18, 18, 19, 19, 19, 20, 20, 20, 20, 21, 21, 21, 21, 22, 22, 22, 22, 22,
    23, 23, 23, 23, 23, 23, 24, 24, 24, 24, 24, 24, 25, 25, 25, 25, 25, 25, 25, 26, 26, 26, 26, 26, 26, 26, 26, 27, 27, 27, 27, 27, 27, 27, 27, 27, 27,
    28, 28, 28, 28, 28, 28, 28, 28, 28, 28, 29, 29, 29, 29, 29, 29, 29, 29, 29, 29, 29, 29, 30, 30, 30, 30, 30, 30, 30, 30, 30, 30, 30, 30, 30, 30,
    31, 31, 31, 31, 31, 31, 31, 31, 31, 31, 31, 31, 31, 31, 31};

__global__ __launch_bounds__(256) void k_transpose_convert(const float* __restrict__ W, int K, int N, bf16_t* __restrict__ WT, int ldk, int row_off, int blk, int blk_stride) {
    __shared__ float tile[32][33];
    const int n0 = blockIdx.x * 32, k0 = blockIdx.y * 32, tx = threadIdx.x & 31, ty = threadIdx.x >> 5;
    for (int i = ty; i < 32; i += 8) tile[i][tx] = W[(size_t)(k0 + i) * N + n0 + tx];
    __syncthreads();
    for (int i = ty; i < 32; i += 8) { const int n = n0 + i; const int row = row_off + (n / blk) * blk_stride + (n % blk);
        WT[(size_t)row * ldk + k0 + tx] = f2bf(tile[tx][i]); }
}
__global__ __launch_bounds__(256) void k_small_tables(const float* __restrict__ ws_in, const float* __restrict__ rel_bias, bf16_t* __restrict__ wsb, float* __restrict__ biasT) {
    const int i = blockIdx.x * 256 + threadIdx.x;
    if (i < 8 * 128 * 128) { const int s = i & 127, t = (i >> 7) & 127; wsb[i] = (s <= t) ? f2bf(ws_in[i]) : (bf16_t)0; }
    if (i < 8 * 128) { const int h = i >> 7, dist = i & 127; biasT[i] = rel_bias[kBucket[dist] * 8 + h] * LOG2E; }
}
__global__ __launch_bounds__(256) void k_rmsnorm_bf16(const float* __restrict__ x, const float* __restrict__ g, bf16_t* __restrict__ out) {
    const int row = blockIdx.x * 4 + (threadIdx.x >> 6), lane = threadIdx.x & 63;
    const f32x4* xr = (const f32x4*)(x + (size_t)row * D);
    f32x4 v[4]; float s = 0.f;
#pragma unroll
    for (int j = 0; j < 4; ++j) { v[j] = xr[lane + 64 * j]; s += v[j].x * v[j].x + v[j].y * v[j].y + v[j].z * v[j].z + v[j].w * v[j].w; }
    const float rstd = rsqrtf(wave_sum(s) * (1.f / D) + EPS);
#pragma unroll
    for (int j = 0; j < 4; ++j) { const f32x4 gv = ((const f32x4*)g)[lane + 64 * j];
        ushort4 o; o.x = f2bf(v[j].x * rstd * gv.x); o.y = f2bf(v[j].y * rstd * gv.y); o.z = f2bf(v[j].z * rstd * gv.z); o.w = f2bf(v[j].w * rstd * gv.w);
        ((ushort4*)(out + (size_t)row * D))[lane + 64 * j] = o; }
}

template <int MODE, class Op>
__global__ __launch_bounds__(256) void k_gemm_simple(Op op) {
    if (!op.active()) return;
    const int wave = threadIdx.x >> 6, lane = threadIdx.x & 63, wy = wave >> 1, wx = wave & 1, fr = lane & 15, fq = lane >> 4;
    const int row0 = blockIdx.y * 64 + wy * 32, col0 = blockIdx.x * 64 + wx * 32;
    f32x4 acc[2][2][2];
#pragma unroll
    for (int s = 0; s < 2; ++s)
#pragma unroll
        for (int i = 0; i < 2; ++i)
#pragma unroll
            for (int j = 0; j < 2; ++j) acc[s][i][j] = (f32x4){0.f, 0.f, 0.f, 0.f};
#pragma unroll
    for (int seg = 0; seg < (MODE == 0 ? 1 : 2); ++seg) {
        const bf16_t* ap[2]; const bf16_t* bp[2];
#pragma unroll
        for (int i = 0; i < 2; ++i) { ap[i] = op.arow(seg, row0 + i * 16 + fr) + fq * 8; bp[i] = op.brow(seg, col0 + i * 16 + fr) + fq * 8; }
        const int K = op.K(seg);
        for (int k = 0; k < K; k += 32) {
            bf16x8 a[2], b[2];
#pragma unroll
            for (int i = 0; i < 2; ++i) { a[i] = *(const bf16x8*)(ap[i] + k); b[i] = *(const bf16x8*)(bp[i] + k); }
#pragma unroll
            for (int i = 0; i < 2; ++i)
#pragma unroll
                for (int j = 0; j < 2; ++j) {
                    if (MODE == 2 && seg == 1) acc[1][i][j] = __builtin_amdgcn_mfma_f32_16x16x32_bf16(a[i], b[j], acc[1][i][j], 0, 0, 0);
                    else acc[0][i][j] = __builtin_amdgcn_mfma_f32_16x16x32_bf16(a[i], b[j], acc[0][i][j], 0, 0, 0);
                }
        }
    }
#pragma unroll
    for (int i = 0; i < 2; ++i)
#pragma unroll
        for (int j = 0; j < 2; ++j)
#pragma unroll
            for (int r = 0; r < 4; ++r) op.epi(row0 + i * 16 + fq * 4 + r, col0 + j * 16 + fr, acc[0][i][j][r], acc[1][i][j][r]);
}

struct OpG1 {
    const bf16_t* hn; const bf16_t* wt; bf16_t *U, *V, *Q, *Kb, *VV, *GA, *GB;
    __device__ bool active() const { return true; }
    __device__ int K(int) const { return D; }
    __device__ const bf16_t* arow(int, int r) const { return hn + (size_t)r * D; }
    __device__ const bf16_t* brow(int, int c) const { return wt + (size_t)c * D; }
    __device__ void epi(int r, int c, float v, float) const {
        if (c < 512) U[(size_t)r * 512 + c] = f2bf(gelu_tanh(v));
        else if (c < 1024) V[(size_t)r * 512 + (c - 512)] = f2bf(gelu_tanh(v));
        else if (c < 1536) Q[(size_t)r * 512 + (c - 1024)] = f2bf(v * (0.125f * LOG2E));
        else if (c < 1664) Kb[(size_t)r * 128 + (c - 1536)] = f2bf(v);
        else if (c < 1792) VV[(size_t)r * 128 + (c - 1664)] = f2bf(v);
        else if (c < 2816) GA[(size_t)r * 1024 + (c - 1792)] = f2bf(sigmoidf_(v));
        else GB[(size_t)r * 1024 + (c - 2816)] = f2bf(sigmoidf_(v));
    }
};
__global__ __launch_bounds__(256) void k_vstat_simple(const bf16_t* __restrict__ V, float* __restrict__ vstat) {
    const int row = blockIdx.x * 4 + (threadIdx.x >> 6), lane = threadIdx.x & 63;
    float s = 0.f, q = 0.f;
    for (int j = 0; j < 8; ++j) { const float v = bf2f(V[(size_t)row * 512 + lane + 64 * j]); s += v; q += v * v; }
    s = wave_sum(s); q = wave_sum(q);
    if (lane < 16) vstat[(size_t)row * 16 + lane] = lane == 0 ? s : (lane == 1 ? q : 0.f);
}
__global__ __launch_bounds__(256) void k_vnorm_simple(const bf16_t* __restrict__ V, const float* __restrict__ vstat, const float* __restrict__ gv, float* __restrict__ vn) {
    const int row = blockIdx.x * 4 + (threadIdx.x >> 6), lane = threadIdx.x & 63;
    float s = 0.f, q = 0.f;
    for (int p = 0; p < 8; ++p) { s += vstat[(size_t)row * 16 + 2 * p]; q += vstat[(size_t)row * 16 + 2 * p + 1]; }
    const float mean = s * (1.f / 512.f), var = fmaxf(q * (1.f / 512.f) - mean * mean, 0.f), rstd = rsqrtf(var + EPS);
    for (int j = 0; j < 8; ++j) { const int c = lane + 64 * j; vn[(size_t)row * 512 + c] = (bf2f(V[(size_t)row * 512 + c]) - mean) * rstd * gv[c]; }
}
__global__ __launch_bounds__(256) void k_gmlp_simple(const bf16_t* __restrict__ U, const float* __restrict__ vn, const bf16_t* __restrict__ wsb, const float* __restrict__ bs, bf16_t* __restrict__ A) {
    const int t = blockIdx.x, tl = t & 127, c0 = t - tl;
    for (int ch = threadIdx.x; ch < 512; ch += 256) {
        const int g = ch >> 6; float acc = 0.f;
        for (int s = 0; s <= tl; ++s) acc += bf2f(wsb[(g * 128 + tl) * 128 + s]) * vn[(size_t)(c0 + s) * 512 + ch];
        const float sv = acc + bs[g * 128 + tl];
        A[(size_t)t * 512 + ch] = f2bf(bf2f(U[(size_t)t * 512 + ch]) * sv);
    }
}
__global__ __launch_bounds__(256) void k_attn_simple(const bf16_t* __restrict__ Q, const bf16_t* __restrict__ Kb, const bf16_t* __restrict__ VV, const float* __restrict__ biasT,
                                                     const float* __restrict__ sinks, bf16_t* __restrict__ B) {
    const int w = blockIdx.x * 4 + (threadIdx.x >> 6), lane = threadIdx.x & 63;
    const int t = w >> 3, h = w & 7, kh = h >> 2, pos = t & (SEQ - 1), bb = t - pos;
    float sc[2]; float m = sinks[h] * LOG2E; const float sink2 = m;
#pragma unroll
    for (int u = 0; u < 2; ++u) {
        const int j = lane + 64 * u, kpos = pos - 127 + j, dist = 127 - j;
        float s = -1e30f;
        if (kpos >= 0) { float a = 0.f; const bf16_t* qp = Q + (size_t)t * 512 + h * 64; const bf16_t* kp = Kb + (size_t)(bb + kpos) * 128 + kh * 64;
            for (int d = 0; d < 64; ++d) a += bf2f(qp[d]) * bf2f(kp[d]);
            s = a + biasT[h * 128 + dist]; }
        sc[u] = s; m = fmaxf(m, s);
    }
    m = wave_max(m);
    float p0 = exp2f(sc[0] - m), p1 = exp2f(sc[1] - m);
    const float denom = wave_sum(p0 + p1) + exp2f(sink2 - m);
    p0 /= denom; p1 /= denom;
    float o = 0.f;
    for (int j = 0; j < 128; ++j) { const float p = __shfl(j < 64 ? p0 : p1, j & 63); const int kpos = pos - 127 + j;
        if (kpos >= 0) o += p * bf2f(VV[(size_t)(bb + kpos) * 128 + kh * 64 + lane]); }
    B[(size_t)t * 512 + h * 64 + lane] = f2bf(o);
}
struct OpG3 {
    const bf16_t *A, *B, *wpa, *wpb, *GA, *GB; bf16_t* M;
    __device__ bool active() const { return true; }
    __device__ int K(int) const { return 512; }
    __device__ const bf16_t* arow(int s, int r) const { return (s ? B : A) + (size_t)r * 512; }
    __device__ const bf16_t* brow(int s, int c) const { return (s ? wpb : wpa) + (size_t)c * 512; }
    __device__ void epi(int r, int c, float v1, float v2) const { const size_t i = (size_t)r * D + c; M[i] = f2bf(bf2f(GA[i]) * v1 + bf2f(GB[i]) * v2); }
};
struct OpG4 {
    const bf16_t *M, *wt; const float* x; float* H;
    __device__ bool active() const { return true; }
    __device__ int K(int) const { return D; }
    __device__ const bf16_t* arow(int, int r) const { return M + (size_t)r * D; }
    __device__ const bf16_t* brow(int, int c) const { return wt + (size_t)c * D; }
    __device__ void epi(int r, int c, float v, float) const { const size_t i = (size_t)r * D + c; H[i] = x[i] + v; }
};
__device__ __forceinline__ void route_token(const float (&lg)[20], const float* __restrict__ rgb, const float* __restrict__ reb, int& cls, float& wa, float& wb) {
    float gl[4]; float gm = -1e30f; int gi = 0;
#pragma unroll
    for (int i = 0; i < 4; ++i) { gl[i] = lg[i] + rgb[i]; if (gl[i] > gm) { gm = gl[i]; gi = i; } }
    float gs = 0.f;
#pragma unroll
    for (int i = 0; i < 4; ++i) gs += __expf(gl[i] - gm);
    const float gp = 1.f / gs;
    float el[4];
#pragma unroll
    for (int i = 0; i < 4; ++i) { float v = 0.f;
#pragma unroll
        for (int g = 0; g < 4; ++g) v = (g == gi) ? lg[4 + g * 4 + i] + reb[g * 4 + i] : v;
        el[i] = v; }
    int i1 = 0; float v1 = el[0];
#pragma unroll
    for (int i = 1; i < 4; ++i) if (el[i] > v1) { v1 = el[i]; i1 = i; }
    int i2 = -1; float v2 = -1e30f;
#pragma unroll
    for (int i = 0; i < 4; ++i) if (i != i1 && (i2 < 0 || el[i] > v2)) { v2 = el[i]; i2 = i; }
    const float e2 = __expf(v2 - v1), w1 = gp / (1.f + e2), w2 = gp * e2 / (1.f + e2);
    const int a = i1 < i2 ? i1 : i2, b = i1 < i2 ? i2 : i1;
    const int pi = (a == 0) ? (b - 1) : ((a == 1) ? (b + 1) : 5);
    cls = gi * 6 + pi; wa = (i1 < i2) ? w1 : w2; wb = (i1 < i2) ? w2 : w1;
}
__global__ __launch_bounds__(256) void k_router_simple(const float* __restrict__ H, const float* __restrict__ g2, const float* __restrict__ rgw, const float* __restrict__ rgb,
                                                       const float* __restrict__ rew, const float* __restrict__ reb, bf16_t* __restrict__ HN2, unsigned* __restrict__ ctl,
                                                       int* __restrict__ list, float* __restrict__ wl) {
    const int row = blockIdx.x * 4 + (threadIdx.x >> 6), lane = threadIdx.x & 63;
    const f32x4* xr = (const f32x4*)(H + (size_t)row * D);
    f32x4 v[4]; float s = 0.f;
#pragma unroll
    for (int j = 0; j < 4; ++j) { v[j] = xr[lane + 64 * j]; s += v[j].x * v[j].x + v[j].y * v[j].y + v[j].z * v[j].z + v[j].w * v[j].w; }
    const float rstd = rsqrtf(wave_sum(s) * (1.f / D) + EPS);
    float lg[20];
#pragma unroll
    for (int o = 0; o < 20; ++o) lg[o] = 0.f;
#pragma unroll
    for (int j = 0; j < 4; ++j) { const f32x4 gv = ((const f32x4*)g2)[lane + 64 * j];
        f32x4 n; n.x = v[j].x * rstd * gv.x; n.y = v[j].y * rstd * gv.y; n.z = v[j].z * rstd * gv.z; n.w = v[j].w * rstd * gv.w;
        ushort4 o; o.x = f2bf(n.x); o.y = f2bf(n.y); o.z = f2bf(n.z); o.w = f2bf(n.w);
        ((ushort4*)(HN2 + (size_t)row * D))[lane + 64 * j] = o;
#pragma unroll
        for (int e = 0; e < 4; ++e) { const int c = 4 * (lane + 64 * j) + e; const float hv = n[e];
            const f32x4 wg = *(const f32x4*)(rgw + (size_t)c * 4);
            lg[0] += hv * wg.x; lg[1] += hv * wg.y; lg[2] += hv * wg.z; lg[3] += hv * wg.w;
#pragma unroll
            for (int g = 0; g < 4; ++g) { const f32x4 we = *(const f32x4*)(rew + ((size_t)g * D + c) * 4);
                lg[4 + g * 4 + 0] += hv * we.x; lg[4 + g * 4 + 1] += hv * we.y; lg[4 + g * 4 + 2] += hv * we.z; lg[4 + g * 4 + 3] += hv * we.w; } } }
#pragma unroll
    for (int o = 0; o < 20; ++o) lg[o] = wave_sum(lg[o]);
    if (lane == 0) { int cls; float wa, wb; route_token(lg, rgb, reb, cls, wa, wb);
        const unsigned rank = atomicAdd(ctl + CW_CNT + 16 * cls, 1u);
        list[(size_t)cls * T + rank] = row; wl[((size_t)cls * T + rank) * 2] = wa; wl[((size_t)cls * T + rank) * 2 + 1] = wb; }
}
__global__ void k_class_offsets(unsigned* ctl) {
    if (threadIdx.x == 0 && blockIdx.x == 0) { unsigned off = 0; for (int c = 0; c < NCLS; ++c) { ctl[CW_OFF + c] = off; off += (ctl[CW_CNT + 16 * c] + 255u) & ~255u; } ctl[CW_OFF + NCLS] = off; }
}
__device__ __forceinline__ void class_experts(int cls, int& e1, int& e2) {
    const int g = cls / 6, pi = cls % 6; const int a = pi < 3 ? 0 : (pi < 5 ? 1 : 2); const int b = pi < 3 ? pi + 1 : (pi < 5 ? pi - 1 : 3);
    e1 = 4 * g + a; e2 = 4 * g + b;
}
struct OpUp {
    const bf16_t *HN2, *wup; const unsigned* ctl; const int* list; const float* wl; bf16_t* HID;
    __device__ bool active() const { return blockIdx.y * 64u < ctl[CW_CNT + 16 * blockIdx.z]; }
    __device__ int K(int) const { return D; }
    __device__ const bf16_t* arow(int, int r) const { const int cls = blockIdx.z; const unsigned cnt = ctl[CW_CNT + 16 * cls]; const int t = (unsigned)r < cnt ? list[(size_t)cls * T + r] : 0; return HN2 + (size_t)t * D; }
    __device__ const bf16_t* brow(int s, int c) const { int e1, e2; class_experts(blockIdx.z, e1, e2); const int e = c < 512 ? e1 : e2, hc = c & 511;
        return wup + ((size_t)e * 1024 + (hc >> 7) * 256 + s * 128 + (hc & 127)) * D; }
    __device__ void epi(int r, int c, float g, float u) const { const int cls = blockIdx.z; const unsigned cnt = ctl[CW_CNT + 16 * cls];
        if ((unsigned)r < cnt) { const float w = wl[((size_t)cls * T + r) * 2 + (c >> 9)]; HID[((size_t)ctl[CW_OFF + cls] + r) * 1024 + c] = f2bf(w * (g / (1.f + __expf(-g))) * u); } }
};
struct OpDown {
    const bf16_t *HID, *wdn; const unsigned* ctl; const int* list; const float* H; float* OUT;
    __device__ bool active() const { return blockIdx.y * 64u < ctl[CW_CNT + 16 * blockIdx.z]; }
    __device__ int K(int) const { return 512; }
    __device__ const bf16_t* arow(int s, int r) const { return HID + ((size_t)ctl[CW_OFF + blockIdx.z] + r) * 1024 + s * 512; }
    __device__ const bf16_t* brow(int s, int c) const { int e1, e2; class_experts(blockIdx.z, e1, e2); return wdn + ((size_t)(s ? e2 : e1) * 1024 + c) * 512; }
    __device__ void epi(int r, int c, float v, float) const { const int cls = blockIdx.z; const unsigned cnt = ctl[CW_CNT + 16 * cls];
        if ((unsigned)r < cnt) { const int t = list[(size_t)cls * T + r]; const size_t i = (size_t)t * D + c; OUT[i] = H[i] + v; } }
};
__global__ __launch_bounds__(256) void k_final_norm(float* __restrict__ out, const float* __restrict__ g) {
    const int row = blockIdx.x * 4 + (threadIdx.x >> 6), lane = threadIdx.x & 63;
    f32x4* xr = (f32x4*)(out + (size_t)row * D);
    f32x4 v[4]; float s = 0.f;
#pragma unroll
    for (int j = 0; j < 4; ++j) { v[j] = xr[lane + 64 * j]; s += v[j].x * v[j].x + v[j].y * v[j].y + v[j].z * v[j].z + v[j].w * v[j].w; }
    const float rstd = rsqrtf(wave_sum(s) * (1.f / D) + EPS);
#pragma unroll
    for (int j = 0; j < 4; ++j) { const f32x4 gv = ((const f32x4*)g)[lane + 64 * j]; f32x4 o; o.x = v[j].x * rstd * gv.x; o.y = v[j].y * rstd * gv.y; o.z = v[j].z * rstd * gv.z; o.w = v[j].w * rstd * gv.w; xr[lane + 64 * j] = o; }
}


#define LAS __attribute__((address_space(3)))
#define GAS __attribute__((address_space(1)))
typedef GAS unsigned gu32;
#define RLX_AGENT __ATOMIC_RELAXED, __HIP_MEMORY_SCOPE_AGENT
#define LDS_WAIT() asm volatile("s_waitcnt lgkmcnt(0)" ::: "memory")
#define VM_WAIT() asm volatile("s_waitcnt vmcnt(0)" ::: "memory")

#define XB_TMO      128
#define XB_XCNT(j)  (256  + 64 * (j))
#define XB_XSUB(j)  (1280 + 64 * (j))
#define XB_XGEN(j)  (2304 + 64 * (j))
#define XB_TOP      3328
#define XB_TOPGEN   3392
#define XCD_BAR_WORDS 3456
#define XB_SPIN_CAP (1u << 18)
__device__ __forceinline__ unsigned xb_ld(unsigned* p)              { return __hip_atomic_load(p, __ATOMIC_RELAXED, __HIP_MEMORY_SCOPE_AGENT); }
__device__ __forceinline__ unsigned xb_add(unsigned* p, unsigned v) { return __hip_atomic_fetch_add(p, v, __ATOMIC_RELAXED, __HIP_MEMORY_SCOPE_AGENT); }
__device__ __forceinline__ unsigned xb_xcc_id() { return (unsigned)__builtin_amdgcn_s_getreg((3 << 11) | 20) & 0xFu; }
#define XB_SPIN(cond, bar) do { unsigned _sp = 0; while (cond) { __builtin_amdgcn_s_sleep(1); \
    if ((++_sp & 255u) == 0u) { if (xb_ld(&(bar)[XB_TMO])) break; if (_sp > XB_SPIN_CAP) { atomicAdd(&(bar)[XB_TMO], 1u); break; } } } } while (0)
struct XcdBarrier { unsigned* bar; unsigned x; volatile LAS unsigned* st; };
__device__ __forceinline__ XcdBarrier xcd_barrier_post(unsigned* bar, volatile LAS unsigned* st) {
    XcdBarrier b; b.bar = bar; b.x = xb_xcc_id(); b.st = st;
    if (threadIdx.x == 0) (void)xb_add(&bar[XB_XCNT(b.x)], 1u);
    return b;
}
__device__ __forceinline__ void xcd_barrier_complete(unsigned* bar, unsigned x, unsigned& nloc, unsigned& nx) {
    const unsigned G = gridDim.x * gridDim.y * gridDim.z;
    unsigned sum, cnt, mine, sp = 0u;
    for (;;) {
        sum = 0u; cnt = 0u; mine = 0u;
#pragma unroll
        for (unsigned j = 0; j < 16; ++j) { const unsigned c = xb_ld(&bar[XB_XCNT(j)]); sum += c; cnt += (c > 0u) ? 1u : 0u; mine = (j == x) ? c : mine; }
        if (sum == G) break;
        __builtin_amdgcn_s_sleep(1);
        if ((++sp & 255u) == 0u) { if (xb_ld(&bar[XB_TMO])) break; if (sp > XB_SPIN_CAP) { atomicAdd(&bar[XB_TMO], 1u); break; } }
    }
    nloc = mine > 0u ? mine : 1u; nx = cnt > 0u ? cnt : 1u;
}
__device__ __forceinline__ void xcd_barrier(const XcdBarrier& b) {
    asm volatile("s_waitcnt vmcnt(0)" ::: "memory");
    __syncthreads();
    if (threadIdx.x == 0) {
        unsigned* bar = b.bar;
        __builtin_amdgcn_s_waitcnt(0);
        unsigned nloc = b.st[0], nx = b.st[1];
        if (nloc == 0u) { xcd_barrier_complete(bar, b.x, nloc, nx); b.st[0] = nloc; b.st[1] = nx; }
        const unsigned old = xb_add(&bar[XB_XSUB(b.x)], 1u);
        const unsigned gen = old / nloc;
        if (old + 1u == (gen + 1u) * nloc) {
            __builtin_amdgcn_fence(__ATOMIC_RELEASE, "agent");
            asm volatile("s_waitcnt vmcnt(0)" ::: "memory");
            const unsigned og = xb_add(&bar[XB_TOP], 1u);
            const unsigned tg = og / nx;
            if (og + 1u == (tg + 1u) * nx) xb_add(&bar[XB_TOPGEN], 1u);
            else XB_SPIN(xb_ld(&bar[XB_TOPGEN]) == tg, bar);
            __builtin_amdgcn_fence(__ATOMIC_ACQUIRE, "agent");
            xb_add(&bar[XB_XGEN(b.x)], 1u);
            asm volatile("s_waitcnt vmcnt(0)" ::: "memory");
        } else {
            XB_SPIN(xb_ld(&bar[XB_XGEN(b.x)]) == gen, bar);
            __builtin_amdgcn_fence(__ATOMIC_ACQUIRE, "agent");
            asm volatile("s_waitcnt vmcnt(0)" ::: "memory");
        }
    }
    __syncthreads();
}

__device__ __forceinline__ int lane_id_fresh() { int l = (int)__builtin_amdgcn_mbcnt_hi(~0u, __builtin_amdgcn_mbcnt_lo(~0u, 0u)); asm volatile("" : "+v"(l)); return l; }
constexpr int RING_OFF = 0, RING_BYTES = 131072;
constexpr int LDSCTL_OFF = RING_BYTES;
constexpr int CTAB_OFF = LDSCTL_OFF + 512;
constexpr int IDX_OFF = LDSCTL_OFF + 1024;
constexpr int LDS_BYTES = 147456;
constexpr int CW_BAR = 4096;

__device__ __forceinline__ unsigned cvt_pk_bf16(float lo, float hi) { unsigned r; asm volatile("v_cvt_pk_bf16_f32 %0, %1, %2" : "=v"(r) : "v"(lo), "v"(hi)); return r; }
__device__ __forceinline__ float fast_sigmoid(float x) { return __builtin_amdgcn_rcpf(1.f + __builtin_amdgcn_exp2f(-LOG2E * x)); }
__device__ __forceinline__ float fast_gelu(float x) {
    const float t = x * (-2.f * LOG2E * 0.7978845608028654f) * (1.f + 0.044715f * x * x);
    return x * __builtin_amdgcn_rcpf(1.f + __builtin_amdgcn_exp2f(t));
}

namespace pg8 {
constexpr int BM = 256, BK = 64, HALF = 128, HTB = HALF * BK * 2, STAGE_BYTES = 8 * HTB, NXCD = 8, WGM = 8;
__host__ __device__ __forceinline__ int lds_byte(int r, int c) { const int st = (r >> 4) * 2 + (c >> 5), rr = r & 15, cc = c & 31, ob = rr * 64 + cc * 2; return st * 1024 + (ob ^ (((ob >> 9) & 1) << 5)); }
__host__ __device__ __forceinline__ void stage_rc(int b, int& R, int& C) { const int st = b / 1024, sb = b % 1024, swz = sb ^ (((sb >> 9) & 1) << 5); R = (st >> 1) * 16 + swz / 64; C = (st & 1) * 32 + (swz % 64) / 2; }
__host__ __device__ __forceinline__ int perm32(int rho) { const int n = rho >> 4, i = rho & 15; return 8 * (i >> 2) + 4 * n + (i & 3); }

struct Unit { const char* A; const char* B0; const char* B1p; int pm, pn, aux, slot; };

struct TileOrder {
    int nM, nN, nwg, G, c;
    __device__ void init(int M, int N, int G_, int c_) { nM = M / BM; nN = N / BM; nwg = nM * nN; G = G_; c = c_; }
    __device__ bool tile(int i, int& pm, int& pn) const {
        const long L = (long)i * G + c; if (L >= nwg) return false;
        int wgid = (int)L; { const int q = nwg / NXCD, r = nwg % NXCD, xcd = wgid % NXCD, off = wgid / NXCD; wgid = (xcd < r ? xcd * (q + 1) : r * (q + 1) + (xcd - r) * q) + off; }
        const int nig = WGM * nN, gid = wgid / nig, fm = gid * WGM, gsz = (nM - fm) < WGM ? (nM - fm) : WGM;
        pm = fm + ((wgid % nig) % gsz); pn = (wgid % nig) / gsz; return true;
    }
};

template <class Epi, class Sched, bool GATHER>
__device__ __forceinline__ void gemm_phase(LAS unsigned char* lds, const int K, const int ldb, const Sched& S, const Epi& E, const LAS int* idx, const int wid) {
    const int lane = lane_id_fresh(), tid = wid * 64 + lane, wr = wid >> 2, wc = wid & 3, fr = lane & 15, fq = lane >> 4;
    const int nt = K / BK, halfk = nt / 2;
    int RA[2], CA[2]; unsigned voffB[2];
#pragma unroll
    for (int i = 0; i < 2; ++i) { int R, C; stage_rc(tid * 16 + i * 8192, R, C); RA[i] = R; CA[i] = C; const int Rb = Epi::PERM ? ((R & ~31) + perm32(R & 31)) : R;
        voffB[i] = (unsigned)(Rb * ldb + C) * 2u; }
    const size_t kstep = (size_t)(BK * 2);
    const size_t hstepB = (size_t)HALF * ldb * 2;
    const unsigned ldsw = (unsigned)wid * 1024u;
    const int aoff = lds_byte(wr * 64 + fr, fq * 8), boff = lds_byte(wc * 32 + fr, fq * 8);
#define PG8_SA(b, h) (((b) * 2 + (h)) * HTB)
#define PG8_SB(b, h) ((4 + (b) * 2 + (h)) * HTB)
#define PG8_STAGE(bufoff, gbase, voff) do { _Pragma("unroll") for (int _i = 0; _i < 2; ++_i) \
        __builtin_amdgcn_global_load_lds((const unsigned*)((const char*)(gbase) + (voff)[_i]), (LAS unsigned*)(lds + (bufoff) + ldsw + _i * 8192), 16, 0, 0); } while (0)
#define PG8_LDA(dst, b, h) do { _Pragma("unroll") for (int m = 0; m < 4; ++m) _Pragma("unroll") for (int k = 0; k < 2; ++k) dst[m][k] = *(const LAS bf16x8*)(lds + PG8_SA(b, h) + aoff + m * 2048 + k * 1024); } while (0)
#define PG8_LDB(dst, b, h) do { _Pragma("unroll") for (int n = 0; n < 2; ++n) _Pragma("unroll") for (int k = 0; k < 2; ++k) dst[n][k] = *(const LAS bf16x8*)(lds + PG8_SB(b, h) + boff + n * 2048 + k * 1024); } while (0)
#define PG8_MMA(ai, bj, At, Bt) do { __builtin_amdgcn_s_setprio(1); _Pragma("unroll") for (int m = 0; m < 4; ++m) _Pragma("unroll") for (int n = 0; n < 2; ++n) _Pragma("unroll") for (int k = 0; k < 2; ++k) \
        acc[ai][bj][m][n] = __builtin_amdgcn_mfma_f32_16x16x32_bf16(Bt[n][k], At[m][k], acc[ai][bj][m][n], 0, 0, 0); __builtin_amdgcn_s_setprio(0); } while (0)
#define PG8_WAIT_V(n) asm volatile("s_waitcnt vmcnt(" #n ")" ::: "memory")
#define PG8_WAIT_L(n) asm volatile("s_waitcnt lgkmcnt(" #n ")" ::: "memory")
#define PG8_BAR __builtin_amdgcn_s_barrier()
#define PG8_SCHED __builtin_amdgcn_sched_barrier(0)
#define PG8_SETVA(va, slot_) do { _Pragma("unroll") for (int _h = 0; _h < 2; ++_h) _Pragma("unroll") for (int _i = 0; _i < 2; ++_i) { \
        if (GATHER) (va)[_h][_i] = (unsigned)(idx[(slot_) * 256 + _h * 128 + RA[_i]] & 0x7fffffff) * (unsigned)(K * 2) + (unsigned)(CA[_i] * 2); \
        else (va)[_h][_i] = (unsigned)((_h * 128 + RA[_i]) * K + CA[_i]) * 2u; } } while (0)
    Unit cur, nxt; int ui = 0;
    if (!S.next(0, cur)) return;
    f32x4 acc[2][2][4][2];
#pragma unroll
    for (int a = 0; a < 2; ++a)
#pragma unroll
        for (int b = 0; b < 2; ++b)
#pragma unroll
            for (int m = 0; m < 4; ++m)
#pragma unroll
                for (int n = 0; n < 2; ++n) acc[a][b][m][n] = (f32x4){0.f, 0.f, 0.f, 0.f};
    bf16x8 At[4][2], B0[2][2], B1[2][2];
    unsigned cva[2][2], nva[2][2];
    PG8_SETVA(cva, cur.slot);
    PG8_STAGE(PG8_SB(0, 0), cur.B0, voffB); PG8_STAGE(PG8_SB(0, 1), cur.B0 + hstepB, voffB); PG8_STAGE(PG8_SA(0, 0), cur.A, cva[0]); PG8_STAGE(PG8_SA(0, 1), cur.A, cva[1]);
    if (wr == 1) PG8_BAR;
    PG8_WAIT_V(2); PG8_BAR;
    PG8_STAGE(PG8_SB(1, 0), cur.B0 + kstep, voffB); PG8_STAGE(PG8_SA(1, 0), cur.A + kstep, cva[0]); PG8_STAGE(PG8_SB(1, 1), cur.B0 + hstepB + kstep, voffB);
    PG8_WAIT_V(6); PG8_BAR;
    for (;;) {
        const bool has_next = S.next(ui + 1, nxt);
        if (!has_next) { nxt.A = cur.A; nxt.B0 = cur.B0; nxt.B1p = cur.B1p; nxt.slot = cur.slot; }
        if (GATHER) { PG8_SETVA(nva, nxt.slot); }
        for (int t = 0; t < nt; t += 2) {
            const bool last = (t == nt - 2);
            const char* a1 = cur.A + (size_t)(t + 1) * kstep;
            const char* a2 = last ? nxt.A : cur.A + (size_t)(t + 2) * kstep;
            const char* b2 = last ? nxt.B0 : ((t + 2 < halfk) ? cur.B0 : cur.B1p) + (size_t)(t + 2) * kstep;
            const char* a3 = a2 + kstep; const char* b3 = b2 + kstep;
            unsigned v20[2], v21[2];
#pragma unroll
            for (int i = 0; i < 2; ++i) { v20[i] = (GATHER && last) ? nva[0][i] : cva[0][i]; v21[i] = (GATHER && last) ? nva[1][i] : cva[1][i]; }
            PG8_LDB(B0, 0, 0); PG8_LDB(B1, 0, 1); PG8_SCHED; PG8_LDA(At, 0, 0); PG8_STAGE(PG8_SA(1, 1), a1, cva[1]);
            PG8_WAIT_V(8); PG8_WAIT_L(0); PG8_BAR; PG8_MMA(0, 0, At, B0); PG8_MMA(0, 1, At, B1); PG8_BAR; PG8_SCHED;
            PG8_LDA(At, 0, 1); PG8_STAGE(PG8_SB(0, 0), b2, voffB); PG8_STAGE(PG8_SB(0, 1), b2 + hstepB, voffB); PG8_STAGE(PG8_SA(0, 0), a2, v20);
            PG8_WAIT_V(8); PG8_WAIT_L(0); PG8_BAR; PG8_MMA(1, 0, At, B0); PG8_MMA(1, 1, At, B1); PG8_BAR; PG8_SCHED;
            PG8_LDB(B0, 1, 0); PG8_LDB(B1, 1, 1); PG8_SCHED; PG8_LDA(At, 1, 0); PG8_STAGE(PG8_SA(0, 1), a2, v21);
            PG8_WAIT_V(8); PG8_WAIT_L(0); PG8_BAR; PG8_MMA(0, 0, At, B0); PG8_MMA(0, 1, At, B1); PG8_BAR; PG8_SCHED;
            PG8_LDA(At, 1, 1); PG8_STAGE(PG8_SB(1, 0), b3, voffB); PG8_STAGE(PG8_SB(1, 1), b3 + hstepB, voffB); PG8_STAGE(PG8_SA(1, 0), a3, v20);
            PG8_WAIT_V(8); PG8_WAIT_L(0); PG8_BAR; PG8_MMA(1, 0, At, B0); PG8_MMA(1, 1, At, B1); PG8_BAR; PG8_SCHED;
        }
        if (wr == 0) PG8_BAR;
        { int fr_e = fr, fq_e = fq; asm volatile("" : "+v"(fr_e), "+v"(fq_e)); E(acc, cur, wr, wc, fr_e, fq_e); }
        if (!has_next) break;
        if (!E.keep_acc(cur)) {
#pragma unroll
            for (int a = 0; a < 2; ++a)
#pragma unroll
                for (int b = 0; b < 2; ++b)
#pragma unroll
                    for (int m = 0; m < 4; ++m)
#pragma unroll
                        for (int n = 0; n < 2; ++n) acc[a][b][m][n] = (f32x4){0.f, 0.f, 0.f, 0.f};
        }
        cur = nxt; ++ui;
        if (GATHER) {
#pragma unroll
            for (int h = 0; h < 2; ++h)
#pragma unroll
                for (int i = 0; i < 2; ++i) cva[h][i] = nva[h][i];
        }
        if (wr == 1) PG8_BAR;
    }
    PG8_WAIT_V(0);
    PG8_BAR;
#undef PG8_SA
#undef PG8_SB
#undef PG8_STAGE
#undef PG8_LDA
#undef PG8_LDB
#undef PG8_MMA
#undef PG8_WAIT_V
#undef PG8_WAIT_L
#undef PG8_BAR
#undef PG8_SCHED
#undef PG8_SETVA
}
}

struct MkArgs {
    const float* in[20]; float* out; unsigned char* ws; int ph_lo, ph_hi, li, pad;
};
enum { PH_PRO = 0, PH_G1 = 1, PH_MIX = 2, PH_G3 = 3, PH_G4 = 4, PH_ROUTE = 5, PH_UP = 6, PH_DOWN = 7, PH_FINAL = 8, PH_N = 9 };

__device__ __forceinline__ unsigned pk2(float lo, float hi) { return (unsigned)f2bf(lo) | ((unsigned)f2bf(hi) << 16); }
__device__ __forceinline__ void p0_transpose_item(const float* W, int K, int N, bf16_t* WT, int row_off, int blk, int blk_stride, LAS float* scr, int item, int lane) {
    const int nblk = N / 32, kb = item / nblk, nb = item % nblk, k0 = 64 * kb, n0 = 32 * nb;
#pragma unroll 8
    for (int i = 0; i < 32; ++i) { const int kk = 2 * i + (lane >> 5); scr[kk * 33 + (lane & 31)] = W[(size_t)(k0 + kk) * N + n0 + (lane & 31)]; }
    LDS_WAIT(); asm volatile("" ::: "memory");
    const int c = lane & 7; const int rbase = row_off + (n0 / blk) * blk_stride + (n0 % blk);
#pragma unroll
    for (int j = 0; j < 4; ++j) { const int n = (lane >> 3) + 8 * j; const LAS float* s = scr + (8 * c) * 33 + n;
        u32x4 o; o.x = pk2(s[0 * 33], s[1 * 33]); o.y = pk2(s[2 * 33], s[3 * 33]); o.z = pk2(s[4 * 33], s[5 * 33]); o.w = pk2(s[6 * 33], s[7 * 33]);
        *(u32x4*)(WT + (size_t)(rbase + n) * K + k0 + 8 * c) = o; }
    LDS_WAIT(); asm volatile("" ::: "memory");
}
__device__ __forceinline__ void rms_row_to_bf16(const float* xrow, const float* g, bf16_t* orow, int lane) {
    const f32x4* xr = (const f32x4*)xrow;
    f32x4 v[4]; float s = 0.f;
#pragma unroll
    for (int j = 0; j < 4; ++j) { v[j] = xr[lane + 64 * j]; s += (v[j].x * v[j].x + v[j].y * v[j].y) + (v[j].z * v[j].z + v[j].w * v[j].w); }
    const float rstd = rsqrtf(wave_sum(s) * (1.f / D) + EPS);
#pragma unroll
    for (int j = 0; j < 4; ++j) { const f32x4 gv = ((const f32x4*)g)[lane + 64 * j];
        uint2 o; o.x = cvt_pk_bf16(v[j].x * rstd * gv.x, v[j].y * rstd * gv.y); o.y = cvt_pk_bf16(v[j].z * rstd * gv.z, v[j].w * rstd * gv.w);
        ((uint2*)orow)[lane + 64 * j] = o; }
}

typedef float f32x2 __attribute__((ext_vector_type(2)));
struct EpiG1 {
    static constexpr bool PERM = true;
    bf16_t *U, *V, *Q, *Kb, *VV, *GA, *GB; float* vstat;
    __device__ __forceinline__ bool keep_acc(const pg8::Unit&) const { return false; }
    __device__ __forceinline__ void operator()(f32x4 (&acc)[2][2][4][2], const pg8::Unit& u, int wr, int wc, int fr, int fq) const {
        const int pn = u.pn, row0 = u.pm * 256 + wr * 64 + fr, cw = wc * 32 + 8 * fq;
        int act, ldc; bf16_t* d0; bf16_t* d1;
        if (pn < 2) { act = 1; ldc = 512; d0 = U + pn * 256 + cw; d1 = d0 + 128; }
        else if (pn < 4) { act = 2; ldc = 512; d0 = V + (pn - 2) * 256 + cw; d1 = d0 + 128; }
        else if (pn < 6) { act = 3; ldc = 512; d0 = Q + (pn - 4) * 256 + cw; d1 = d0 + 128; }
        else if (pn == 6) { act = 0; ldc = 128; d0 = Kb + cw; d1 = VV + cw; }
        else if (pn < 11) { act = 4; ldc = 1024; d0 = GA + (pn - 7) * 256 + cw; d1 = d0 + 128; }
        else { act = 4; ldc = 1024; d0 = GB + (pn - 11) * 256 + cw; d1 = d0 + 128; }
#pragma unroll
        for (int ai = 0; ai < 2; ++ai)
#pragma unroll
            for (int m = 0; m < 4; ++m) {
                const int row = row0 + ai * 128 + m * 16; float s = 0.f, q = 0.f;
#pragma unroll
                for (int bj = 0; bj < 2; ++bj) {
                    f32x4 v0 = acc[ai][bj][m][0], v1 = acc[ai][bj][m][1];
                    if (act == 1 || act == 2) {
#pragma unroll
                        for (int e = 0; e < 4; ++e) { v0[e] = fast_gelu(v0[e]); v1[e] = fast_gelu(v1[e]); }
                        if (act == 2) {
#pragma unroll
                            for (int e = 0; e < 4; ++e) { s += v0[e] + v1[e]; q += v0[e] * v0[e] + v1[e] * v1[e]; }
                        }
                    } else if (act == 3) { v0 = v0 * (0.125f * LOG2E); v1 = v1 * (0.125f * LOG2E); }
                    else if (act == 4) {
#pragma unroll
                        for (int e = 0; e < 4; ++e) { v0[e] = fast_sigmoid(v0[e]); v1[e] = fast_sigmoid(v1[e]); }
                    }
                    u32x4 w; w.x = cvt_pk_bf16(v0[0], v0[1]); w.y = cvt_pk_bf16(v0[2], v0[3]); w.z = cvt_pk_bf16(v1[0], v1[1]); w.w = cvt_pk_bf16(v1[2], v1[3]);
                    *(u32x4*)((bj ? d1 : d0) + (size_t)row * ldc) = w;
                }
                if (act == 2) {
                    s += __shfl_xor(s, 16); s += __shfl_xor(s, 32); q += __shfl_xor(q, 16); q += __shfl_xor(q, 32);
                    if (fq == 0) *(f32x2*)(vstat + (size_t)row * 16 + ((pn - 2) * 4 + wc) * 2) = (f32x2){s, q};
                }
            }
    }
};
struct SchedG1 {
    pg8::TileOrder o; const char* A; const char* B;
    __device__ __forceinline__ bool next(int i, pg8::Unit& u) const { int pm, pn; if (!o.tile(i, pm, pn)) return false;
        u.A = A + (size_t)pm * 256 * D * 2; u.B0 = B + (size_t)pn * 256 * D * 2; u.B1p = u.B0; u.pm = pm; u.pn = pn; u.aux = 0; u.slot = 0; return true; }
};
struct EpiG3 {
    static constexpr bool PERM = true;
    const bf16_t *GA, *GB; bf16_t* M;
    __device__ __forceinline__ bool keep_acc(const pg8::Unit& u) const { return u.aux == 0; }
    __device__ __forceinline__ void operator()(f32x4 (&acc)[2][2][4][2], const pg8::Unit& u, int wr, int wc, int fr, int fq) const {
        const int row0 = u.pm * 256 + wr * 64 + fr, col0 = u.pn * 256 + wc * 32 + 8 * fq;
#pragma unroll
        for (int ai = 0; ai < 2; ++ai)
#pragma unroll
            for (int m = 0; m < 4; ++m)
#pragma unroll
                for (int bj = 0; bj < 2; ++bj) {
                    const size_t off = (size_t)(row0 + ai * 128 + m * 16) * D + col0 + bj * 128;
                    const u32x4 gb = *(const u32x4*)(GB + off);
                    float b[8];
#pragma unroll
                    for (int e = 0; e < 4; ++e) { b[2 * e] = __uint_as_float(gb[e] << 16); b[2 * e + 1] = __uint_as_float(gb[e] & 0xffff0000u); }
                    if (u.aux == 0) {
                        const u32x4 ga = *(const u32x4*)(GA + off);
#pragma unroll
                        for (int e = 0; e < 4; ++e) { const float a0 = __uint_as_float(ga[e] << 16), a1 = __uint_as_float(ga[e] & 0xffff0000u);
                            const float r0 = a0 * __builtin_amdgcn_rcpf(fmaxf(b[2 * e], 1e-30f)), r1 = a1 * __builtin_amdgcn_rcpf(fmaxf(b[2 * e + 1], 1e-30f));
                            const int n = e >> 1, k = (e & 1) * 2; acc[ai][bj][m][n][k] *= r0; acc[ai][bj][m][n][k + 1] *= r1; }
                    } else {
                        const f32x4 v0 = acc[ai][bj][m][0], v1 = acc[ai][bj][m][1];
                        u32x4 w; w.x = cvt_pk_bf16(v0[0] * b[0], v0[1] * b[1]); w.y = cvt_pk_bf16(v0[2] * b[2], v0[3] * b[3]);
                        w.z = cvt_pk_bf16(v1[0] * b[4], v1[1] * b[5]); w.w = cvt_pk_bf16(v1[2] * b[6], v1[3] * b[7]);
                        *(u32x4*)(M + off) = w;
                    }
                }
    }
};
struct SchedG3 {
    pg8::TileOrder o; const char *A, *B, *WA, *WB;
    __device__ __forceinline__ bool next(int j, pg8::Unit& u) const { int pm, pn; if (!o.tile(j >> 1, pm, pn)) return false; const int w = j & 1;
        u.A = (w ? B : A) + (size_t)pm * 256 * 512 * 2; u.B0 = (w ? WB : WA) + (size_t)pn * 256 * 512 * 2; u.B1p = u.B0; u.pm = pm; u.pn = pn; u.aux = w; u.slot = 0; return true; }
};
struct EpiG4 {
    static constexpr bool PERM = false;
    const float* x; float* H;
    __device__ __forceinline__ bool keep_acc(const pg8::Unit&) const { return false; }
    __device__ __forceinline__ void operator()(f32x4 (&acc)[2][2][4][2], const pg8::Unit& u, int wr, int wc, int fr, int fq) const {
        const int row0 = u.pm * 256 + wr * 64 + fr, col0 = u.pn * 256 + wc * 32 + 4 * fq;
#pragma unroll
        for (int ai = 0; ai < 2; ++ai)
#pragma unroll
            for (int m = 0; m < 4; ++m)
#pragma unroll
                for (int bj = 0; bj < 2; ++bj)
#pragma unroll
                    for (int n = 0; n < 2; ++n) { const size_t off = (size_t)(row0 + ai * 128 + m * 16) * D + col0 + bj * 128 + n * 16;
                        *(f32x4*)(H + off) = *(const f32x4*)(x + off) + acc[ai][bj][m][n]; }
    }
};
struct SchedG4 {
    pg8::TileOrder o; const char* A; const char* B;
    __device__ __forceinline__ bool next(int i, pg8::Unit& u) const { int pm, pn; if (!o.tile(i, pm, pn)) return false;
        u.A = A + (size_t)pm * 256 * D * 2; u.B0 = B + (size_t)pn * 256 * D * 2; u.B1p = u.B0; u.pm = pm; u.pn = pn; u.aux = 0; u.slot = 0; return true; }
};
__device__ __forceinline__ int class_of_tile(const LAS int* ctab, int mt) { int cls = 0;
#pragma unroll 1
    for (int c = 0; c < NCLS; ++c) if (mt * 256 >= ctab[c + 1]) cls = c + 1;
    return cls; }
struct SchedUp {
    const LAS int* ctab; const char* A; const char* W; int G, c;
    __device__ __forceinline__ bool next(int i, pg8::Unit& u) const { const int L = i * G + c, NU = (ctab[NCLS] >> 8) * 8; if (L >= NU) return false;
        const int mt = L >> 3, j = L & 7, cls = class_of_tile(ctab, mt); int e1, e2; class_experts(cls, e1, e2); const int e = j < 4 ? e1 : e2;
        u.A = A; u.B0 = W + ((size_t)e * 1024 + (j & 3) * 256) * D * 2; u.B1p = u.B0; u.pm = mt; u.pn = j; u.aux = cls; u.slot = i; return true; }
};
struct EpiUp {
    static constexpr bool PERM = true;
    const LAS int* ctab; const float* wl; bf16_t* HID;
    __device__ __forceinline__ bool keep_acc(const pg8::Unit&) const { return false; }
    __device__ __forceinline__ void operator()(f32x4 (&acc)[2][2][4][2], const pg8::Unit& u, int wr, int wc, int fr, int fq) const {
        const int cls = u.aux, sel = u.pn >> 2, rank0 = u.pm * 256 - ctab[cls], cnt = ctab[32 + cls];
        const int col0 = sel * 512 + (u.pn & 3) * 128 + wc * 32 + 8 * fq;
#pragma unroll
        for (int ai = 0; ai < 2; ++ai)
#pragma unroll
            for (int m = 0; m < 4; ++m) {
                const int R = ai * 128 + wr * 64 + m * 16 + fr, rank = rank0 + R;
                const float w = rank < cnt ? wl[((size_t)cls * T + rank) * 2 + sel] : 0.f;
                const f32x4 g0 = acc[ai][0][m][0], g1 = acc[ai][0][m][1], u0 = acc[ai][1][m][0], u1 = acc[ai][1][m][1];
                float h[8];
#pragma unroll
                for (int e = 0; e < 4; ++e) { h[e] = w * g0[e] * fast_sigmoid(g0[e]) * u0[e]; h[4 + e] = w * g1[e] * fast_sigmoid(g1[e]) * u1[e]; }
                u32x4 o; o.x = cvt_pk_bf16(h[0], h[1]); o.y = cvt_pk_bf16(h[2], h[3]); o.z = cvt_pk_bf16(h[4], h[5]); o.w = cvt_pk_bf16(h[6], h[7]);
                *(u32x4*)(HID + ((size_t)u.pm * 256 + R) * 1024 + col0) = o;
            }
    }
};
struct SchedDown {
    const LAS int* ctab; const char* A; const char* W; int G, c;
    __device__ __forceinline__ bool next(int i, pg8::Unit& u) const { const int L = i * G + c, NU = (ctab[NCLS] >> 8) * 4; if (L >= NU) return false;
        const int mt = L >> 2, j = L & 3, cls = class_of_tile(ctab, mt); int e1, e2; class_experts(cls, e1, e2);
        u.A = A + (size_t)mt * 256 * 1024 * 2; u.B0 = W + ((size_t)e1 * 1024 + j * 256) * 512 * 2; u.B1p = W + ((size_t)e2 * 1024 + j * 256) * 512 * 2 - 8 * 128;
        u.pm = mt; u.pn = j; u.aux = cls; u.slot = i; return true; }
};
struct EpiDown {
    static constexpr bool PERM = false;
    const LAS int* idx; const float* H; float* OUT;
    __device__ __forceinline__ bool keep_acc(const pg8::Unit&) const { return false; }
    __device__ __forceinline__ void operator()(f32x4 (&acc)[2][2][4][2], const pg8::Unit& u, int wr, int wc, int fr, int fq) const {
        const int col0 = u.pn * 256 + wc * 32 + 4 * fq;
#pragma unroll
        for (int ai = 0; ai < 2; ++ai)
#pragma unroll
            for (int m = 0; m < 4; ++m) {
                const int tok = idx[u.slot * 256 + ai * 128 + wr * 64 + m * 16 + fr];
                if (tok >= 0) {
#pragma unroll
                    for (int bj = 0; bj < 2; ++bj)
#pragma unroll
                        for (int n = 0; n < 2; ++n) { const size_t off = (size_t)tok * D + col0 + bj * 128 + n * 16;
                            *(f32x4*)(OUT + off) = *(const f32x4*)(H + off) + acc[ai][bj][m][n]; }
                }
            }
    }
};
template <int NTN>
__device__ __forceinline__ void fill_idx(LAS int* idx, const LAS int* ctab, const int* list, int G, int c, const int tid) {
    const int NU = (ctab[NCLS] >> 8) * NTN;
    for (int i = 0; i < 8; ++i) { const int L = i * G + c; if (L >= NU) break;
        const int mt = L / NTN, cls = class_of_tile(ctab, mt);
        if (tid < 256) { const int rank = mt * 256 + tid - ctab[cls], cnt = ctab[32 + cls];
            idx[i * 256 + tid] = rank < cnt ? list[(size_t)cls * T + rank] : (list[(size_t)cls * T] | (int)0x80000000); } }
    __syncthreads();
}


typedef float f32x16 __attribute__((ext_vector_type(16)));
typedef short s16x4 __attribute__((ext_vector_type(4)));
typedef __bf16 bf16x2_t __attribute__((ext_vector_type(2)));
__device__ __forceinline__ unsigned cvtpk_c(float lo, float hi) { f32x2 v = {lo, hi}; bf16x2_t b = __builtin_convertvector(v, bf16x2_t); return __builtin_bit_cast(unsigned, b); }
__device__ __forceinline__ s16x4 lds_tr16(const LAS unsigned char* p) { return __builtin_bit_cast(s16x4, __builtin_amdgcn_ds_read_tr16_b64_v4i16((LAS s16x4*)p)); }
constexpr int VN_PITCH = 144;
__device__ __forceinline__ void gmlp_phase(LAS unsigned char* lds, const bf16_t* U, const bf16_t* V, const float* vstat, const float* gv, const bf16_t* wsb, const float* bs, bf16_t* A, int G, int bx, const int wave) {
    const int lane = lane_id_fresh(), tid = wave * 64 + lane, fr = lane & 15, fq = lane >> 4, q4 = fr >> 2, p4 = fr & 3;
    LAS unsigned char* VN = lds; LAS float* st = (LAS float*)(lds + 128 * VN_PITCH);
    for (int chunk = bx; chunk < T / 128; chunk += G) {
        __syncthreads();
        if (tid < 128) { const int row = chunk * 128 + tid; float s = 0.f, q = 0.f;
#pragma unroll
            for (int p = 0; p < 8; ++p) { const f32x2 v = *(const f32x2*)(vstat + (size_t)row * 16 + 2 * p); s += v.x; q += v.y; }
            const float mean = s * (1.f / 512.f), var = fmaxf(q * (1.f / 512.f) - mean * mean, 0.f); st[tid * 2] = mean; st[tid * 2 + 1] = rsqrtf(var + EPS); }
        for (int g = 0; g < 8; ++g) {
            __syncthreads();
            { const int s = tid >> 2, d0 = (tid & 3) * 16; const float mean = st[s * 2], rstd = st[s * 2 + 1];
              const bf16_t* src = V + (size_t)(chunk * 128 + s) * 512 + g * 64 + d0;
#pragma unroll
              for (int hh = 0; hh < 2; ++hh) { const u32x4 raw = *(const u32x4*)(src + 8 * hh); const f32x4 g0 = *(const f32x4*)(gv + g * 64 + d0 + 8 * hh), g1 = *(const f32x4*)(gv + g * 64 + d0 + 8 * hh + 4);
                  float f[8];
#pragma unroll
                  for (int e = 0; e < 4; ++e) { f[2 * e] = __uint_as_float(raw[e] << 16); f[2 * e + 1] = __uint_as_float(raw[e] & 0xffff0000u); }
                  u32x4 o; o.x = cvtpk_c((f[0] - mean) * rstd * g0[0], (f[1] - mean) * rstd * g0[1]); o.y = cvtpk_c((f[2] - mean) * rstd * g0[2], (f[3] - mean) * rstd * g0[3]);
                  o.z = cvtpk_c((f[4] - mean) * rstd * g1[0], (f[5] - mean) * rstd * g1[1]); o.w = cvtpk_c((f[6] - mean) * rstd * g1[2], (f[7] - mean) * rstd * g1[3]);
                  *(LAS u32x4*)(VN + s * VN_PITCH + (d0 + 8 * hh) * 2) = o; } }
            __syncthreads();
            f32x4 acc[4];
#pragma unroll
            for (int nb = 0; nb < 4; ++nb) acc[nb] = (f32x4){0.f, 0.f, 0.f, 0.f};
            const int nk = (wave >> 1) + 1;
            const bf16_t* wrow = wsb + (size_t)(g * 128 + 16 * wave + fr) * 128 + 8 * fq;
            for (int kk = 0; kk < nk; ++kk) {
                const bf16x8 a = *(const bf16x8*)(wrow + 32 * kk);
                const LAS unsigned char* vp = VN + (32 * kk + 8 * fq + q4) * VN_PITCH + 8 * p4;
#pragma unroll
                for (int nb = 0; nb < 4; ++nb) { const s16x4 lo = lds_tr16(vp + 32 * nb), hi = lds_tr16(vp + 4 * VN_PITCH + 32 * nb);
                    const bf16x8 b = __builtin_shufflevector(lo, hi, 0, 1, 2, 3, 4, 5, 6, 7);
                    acc[nb] = __builtin_amdgcn_mfma_f32_16x16x32_bf16(b, a, acc[nb], 0, 0, 0); }
            }
            { const int t = 16 * wave + fr; const float bias = bs[g * 128 + t]; const size_t o = (size_t)(chunk * 128 + t) * 512 + g * 64 + 4 * fq;
#pragma unroll
              for (int nb = 0; nb < 4; ++nb) { const uint2 uu = *(const uint2*)(U + o + 16 * nb);
                  const float u0 = __uint_as_float(uu.x << 16), u1 = __uint_as_float(uu.x & 0xffff0000u), u2 = __uint_as_float(uu.y << 16), u3 = __uint_as_float(uu.y & 0xffff0000u);
                  uint2 w; w.x = cvtpk_c(u0 * (acc[nb][0] + bias), u1 * (acc[nb][1] + bias)); w.y = cvtpk_c(u2 * (acc[nb][2] + bias), u3 * (acc[nb][3] + bias));
                  *(uint2*)(A + o + 16 * nb) = w; } }
        }
    }
}
constexpr int AK_PITCH = 144, AV_PITCH = 192, AT_K = 0, AT_V = 256 * AK_PITCH, AT_BIAS = AT_V + 256 * AV_PITCH, AT_LSC = AT_BIAS + 2048;
__device__ __forceinline__ void attn_phase(LAS unsigned char* lds, const bf16_t* Q, const bf16_t* Kb, const bf16_t* VV, const float* biasT, const float* sinks, bf16_t* B, int G, int bx, const int wave) {
    const int lane = lane_id_fresh(), tid = wave * 64 + lane, r32 = lane & 31, h2 = lane >> 5;
    const int q4 = (lane & 15) >> 2, p4 = lane & 3, blk2 = (lane >> 4) & 1;
    LAS unsigned char* Kl = lds + AT_K; LAS unsigned char* Vl = lds + AT_V; LAS float* biasL = (LAS float*)(lds + AT_BIAS); LAS float* lsc = (LAS float*)(lds + AT_LSC) + wave * 32;
    for (int unit = bx; unit < 512; unit += G) {
        const int kh = unit & 1, blk = unit >> 1, n = blk & 31, tok0 = blk * 128;
        __syncthreads();
#pragma unroll
        for (int it = 0; it < 4; ++it) { const int id = it * 512 + tid, row = id >> 3, ch = id & 7;
            u32x4 kv = (u32x4){0u, 0u, 0u, 0u}, vv = (u32x4){0u, 0u, 0u, 0u};
            if (n > 0 || row >= 128) { const size_t src = (size_t)(tok0 - 128 + row) * 128 + kh * 64 + ch * 8; kv = *(const u32x4*)(Kb + src); vv = *(const u32x4*)(VV + src); }
            *(LAS u32x4*)(Kl + row * AK_PITCH + ch * 16) = kv; *(LAS u32x4*)(Vl + row * AV_PITCH + ch * 16) = vv; }
        biasL[tid] = biasT[kh * 512 + tid];
        __syncthreads();
        const int hq = wave >> 1, head = kh * 4 + hq;
        const float sink2 = sinks[head] * LOG2E;
#pragma unroll 1
        for (int qq = 0; qq < 2; ++qq) {
            const int qs = (wave & 1) * 2 + qq;
            bf16x8 qf[4]; { const bf16_t* qp = Q + (size_t)(tok0 + 32 * qs + r32) * 512 + head * 64 + 8 * h2;
#pragma unroll
                for (int ks = 0; ks < 4; ++ks) qf[ks] = *(const bf16x8*)(qp + 16 * ks); }
            f32x16 S[5];
#pragma unroll
            for (int kt = 0; kt < 5; ++kt) {
#pragma unroll
                for (int r = 0; r < 16; ++r) S[kt][r] = 0.f;
                const LAS unsigned char* kp = Kl + (32 * (qs + kt) + r32) * AK_PITCH + 16 * h2;
#pragma unroll
                for (int ks = 0; ks < 4; ++ks) { const bf16x8 kf = *(const LAS bf16x8*)(kp + 32 * ks); S[kt] = __builtin_amdgcn_mfma_f32_32x32x16_bf16(kf, qf[ks], S[kt], 0, 0, 0); }
            }
            float m = sink2;
#pragma unroll
            for (int kt = 0; kt < 5; ++kt) {
                const bool tile_ok = (n > 0) || (qs + kt >= 4);
#pragma unroll
                for (int r = 0; r < 16; ++r) { const int cr = (r & 3) + 8 * (r >> 2) + 4 * h2; const int dist = 128 - 32 * kt + r32 - cr;
                    bool valid = tile_ok; if (kt == 0) valid = valid && (dist < 128); if (kt == 4) valid = valid && (dist >= 0);
                    const float s = valid ? S[kt][r] + biasL[hq * 128 + (dist & 127)] : -1e30f;
                    S[kt][r] = s; m = fmaxf(m, s); }
            }
            m = fmaxf(m, __shfl_xor(m, 32));
            float l = 0.f;
#pragma unroll
            for (int kt = 0; kt < 5; ++kt)
#pragma unroll
                for (int r = 0; r < 16; ++r) { const float p = __builtin_amdgcn_exp2f(S[kt][r] - m); S[kt][r] = p; l += p; }
            l += __shfl_xor(l, 32); l += __builtin_amdgcn_exp2f(sink2 - m);
            if (h2 == 0) lsc[r32] = 1.f / l;
            f32x16 O[2];
#pragma unroll
            for (int r = 0; r < 16; ++r) { O[0][r] = 0.f; O[1][r] = 0.f; }
#pragma unroll
            for (int kt = 0; kt < 5; ++kt)
#pragma unroll
                for (int s2 = 0; s2 < 2; ++s2) {
                    u32x4 pw; pw.x = cvtpk_c(S[kt][8 * s2 + 0], S[kt][8 * s2 + 1]); pw.y = cvtpk_c(S[kt][8 * s2 + 2], S[kt][8 * s2 + 3]);
                    pw.z = cvtpk_c(S[kt][8 * s2 + 4], S[kt][8 * s2 + 5]); pw.w = cvtpk_c(S[kt][8 * s2 + 6], S[kt][8 * s2 + 7]);
                    const bf16x8 pa = __builtin_bit_cast(bf16x8, pw);
                    const LAS unsigned char* vp = Vl + (32 * (qs + kt) + 16 * s2 + 4 * h2 + q4) * AV_PITCH + (16 * blk2 + 4 * p4) * 2;
#pragma unroll
                    for (int db = 0; db < 2; ++db) { const s16x4 lo = lds_tr16(vp + 64 * db), hi = lds_tr16(vp + 8 * AV_PITCH + 64 * db);
                        const bf16x8 vb = __builtin_shufflevector(lo, hi, 0, 1, 2, 3, 4, 5, 6, 7);
                        O[db] = __builtin_amdgcn_mfma_f32_32x32x16_bf16(pa, vb, O[db], 0, 0, 0); }
                }
#pragma unroll
            for (int r = 0; r < 16; ++r) { const int cr = (r & 3) + 8 * (r >> 2) + 4 * h2; const float rl = lsc[cr];
                bf16_t* op = B + (size_t)(tok0 + 32 * qs + cr) * 512 + head * 64 + r32;
                op[0] = f2bf(O[0][r] * rl); op[32] = f2bf(O[1][r] * rl); }
        }
    }
}

__global__ void __launch_bounds__(512, 2) mk_fwd(MkArgs args) {
    extern __shared__ __attribute__((aligned(16))) unsigned char lds_raw[];
    LAS unsigned char* lds = (LAS unsigned char*)lds_raw;
    volatile LAS unsigned* MISC = (volatile LAS unsigned*)(lds + LDSCTL_OFF);
    LAS int* ctab = (LAS int*)(lds + CTAB_OFF);
    LAS int* idx = (LAS int*)(lds + IDX_OFF);
    const int wave = __builtin_amdgcn_readfirstlane((int)threadIdx.x >> 6);
#define lane lane_id_fresh()
#define tid (wave * 64 + lane_id_fresh())
    const int G = gridDim.x, bx = blockIdx.x; const int vcu = (G % 8 == 0) ? (bx % 8) * (G / 8) + bx / 8 : bx;
    unsigned char* ws = args.ws;
    unsigned* ctl = (unsigned*)(ws + WS_CTL);
    const float* x = args.in[0];
    bf16_t* WIN = (bf16_t*)(ws + WS_WIN); bf16_t* WPA = (bf16_t*)(ws + WS_WPA); bf16_t* WPB = (bf16_t*)(ws + WS_WPB); bf16_t* WOUT = (bf16_t*)(ws + WS_WOUT);
    bf16_t* WUP = (bf16_t*)(ws + WS_WUP); bf16_t* WDN = (bf16_t*)(ws + WS_WDN); bf16_t* WSB = (bf16_t*)(ws + WS_WSB); float* BIAS = (float*)(ws + WS_BIAS);
    bf16_t* HN = (bf16_t*)(ws + WS_HN); bf16_t* U = (bf16_t*)(ws + WS_U); bf16_t* V = (bf16_t*)(ws + WS_V); bf16_t* Q = (bf16_t*)(ws + WS_Q); bf16_t* Kb = (bf16_t*)(ws + WS_K);
    bf16_t* VV = (bf16_t*)(ws + WS_VV); bf16_t* GA = (bf16_t*)(ws + WS_GA); bf16_t* GB = (bf16_t*)(ws + WS_GB); bf16_t* A = (bf16_t*)(ws + WS_A); bf16_t* B = (bf16_t*)(ws + WS_B);
    float* H = (float*)(ws + WS_H); bf16_t* HID = (bf16_t*)(ws + WS_HID); float* VSTAT = (float*)(ws + WS_VSTAT); int* LIST = (int*)(ws + WS_LIST); float* WL = (float*)(ws + WS_WL);
    bf16_t* MERGED = HN; bf16_t* HN2 = HN;

    for (int u = tid; u < 128; u += 512) MISC[u] = 0u;
    __syncthreads();
    XcdBarrier bar = xcd_barrier_post(ctl + CW_BAR + args.li * XCD_BAR_WORDS, MISC + 8);
    const int lo = args.ph_lo, hi = args.ph_hi;
#define IN(k) (lo <= (k) && (k) < hi)
#define SEAM(k) do { if (IN(k) && IN((k) + 1)) xcd_barrier(bar); } while (0)

    if (IN(PH_PRO)) {
        LAS float* scr = (LAS float*)(lds + RING_OFF + wave * 16384);
        const int gw = vcu * 8 + wave, NGW = G * 8;
        constexpr int I_IN = (D / 64) * (NIN / 32), I_P = (512 / 64) * (D / 32), I_O = (D / 64) * (D / 32), I_G = (D / 64) * (FF / 32), I_D = (FF / 64) * (D / 32);
        constexpr int NITEMS = I_IN + 2 * I_P + I_O + NEXP * (2 * I_G + I_D);
        for (int it = gw; it < NITEMS; it += NGW) {
            int r = it;
            if (r < I_IN) { p0_transpose_item(args.in[2], D, NIN, WIN, 0, NIN, NIN, scr, r, lane); continue; } r -= I_IN;
            if (r < I_P) { p0_transpose_item(args.in[8], 512, D, WPA, 0, D, D, scr, r, lane); continue; } r -= I_P;
            if (r < I_P) { p0_transpose_item(args.in[9], 512, D, WPB, 0, D, D, scr, r, lane); continue; } r -= I_P;
            if (r < I_O) { p0_transpose_item(args.in[10], D, D, WOUT, 0, D, D, scr, r, lane); continue; } r -= I_O;
            const int e = r / (2 * I_G + I_D); r -= e * (2 * I_G + I_D);
            if (r < I_G) { p0_transpose_item(args.in[16] + (size_t)e * D * FF, D, FF, WUP + (size_t)e * 1024 * D, 0, 128, 256, scr, r, lane); continue; } r -= I_G;
            if (r < I_G) { p0_transpose_item(args.in[17] + (size_t)e * D * FF, D, FF, WUP + (size_t)e * 1024 * D, 128, 128, 256, scr, r, lane); continue; } r -= I_G;
            p0_transpose_item(args.in[18] + (size_t)e * FF * D, FF, D, WDN + (size_t)e * 1024 * FF, 0, D, D, scr, r, lane);
        }
        for (int i = (vcu * 512 + tid); i < 8 * 128 * 128; i += G * 512) { const int s = i & 127, t = (i >> 7) & 127; WSB[i] = (s <= t) ? f2bf(args.in[4][i]) : (bf16_t)0; }
        for (int i = (vcu * 512 + tid); i < 8 * 128; i += G * 512) { const int h = i >> 7, dist = i & 127; BIAS[i] = args.in[7][kBucket[dist] * 8 + h] * LOG2E; }
        for (int m = gw; m < T; m += NGW) rms_row_to_bf16(x + (size_t)m * D, args.in[1], HN + (size_t)m * D, lane);
    }
    SEAM(PH_PRO);
    if (IN(PH_G1)) {
        SchedG1 S; S.o.init(T, NIN, G, bx); S.A = (const char*)HN; S.B = (const char*)WIN;
        EpiG1 E{U, V, Q, Kb, VV, GA, GB, VSTAT};
        pg8::gemm_phase<EpiG1, SchedG1, false>(lds + RING_OFF, D, D, S, E, idx, wave);
    }
    SEAM(PH_G1);
    if (IN(PH_MIX)) {
        gmlp_phase(lds + RING_OFF, U, V, VSTAT, args.in[3], WSB, args.in[5], A, G, bx, wave);
        attn_phase(lds + RING_OFF, Q, Kb, VV, BIAS, args.in[6], B, G, bx, wave);
    }
    SEAM(PH_MIX);
    if (IN(PH_G3)) {
        SchedG3 S; S.o.init(T, D, G, bx); S.A = (const char*)A; S.B = (const char*)B; S.WA = (const char*)WPA; S.WB = (const char*)WPB;
        EpiG3 E{GA, GB, MERGED};
        pg8::gemm_phase<EpiG3, SchedG3, false>(lds + RING_OFF, 512, 512, S, E, idx, wave);
    }
    SEAM(PH_G3);
    if (IN(PH_G4)) {
        SchedG4 S; S.o.init(T, D, G, bx); S.A = (const char*)MERGED; S.B = (const char*)WOUT;
        EpiG4 E{x, H};
        pg8::gemm_phase<EpiG4, SchedG4, false>(lds + RING_OFF, D, D, S, E, idx, wave);
    }
    SEAM(PH_G4);
    if (IN(PH_ROUTE)) {
        LAS int* rcls = (LAS int*)(lds + RING_OFF); LAS float* rwa = (LAS float*)(lds + RING_OFF + 512); LAS float* rwb = (LAS float*)(lds + RING_OFF + 1024); LAS int* rbase = (LAS int*)(lds + RING_OFF + 1536);
        const float* g2 = args.in[11]; const float* rgw = args.in[12]; const float* rgb = args.in[13]; const float* rew = args.in[14]; const float* reb = args.in[15];
        for (int chunk = bx; chunk < T / 128; chunk += G) {
            for (int k = 0; k < 16; ++k) {
                const int tl = wave * 16 + k, row = chunk * 128 + tl;
                const f32x4* xr = (const f32x4*)(H + (size_t)row * D);
                f32x4 v[4]; float s = 0.f;
#pragma unroll
                for (int j = 0; j < 4; ++j) { v[j] = xr[lane + 64 * j]; s += (v[j].x * v[j].x + v[j].y * v[j].y) + (v[j].z * v[j].z + v[j].w * v[j].w); }
                const float rstd = rsqrtf(wave_sum(s) * (1.f / D) + EPS);
                float lg[20];
#pragma unroll
                for (int o = 0; o < 20; ++o) lg[o] = 0.f;
#pragma unroll
                for (int j = 0; j < 4; ++j) { const f32x4 gv = ((const f32x4*)g2)[lane + 64 * j];
                    const f32x4 n = v[j] * rstd * gv;
                    uint2 o; o.x = cvt_pk_bf16(n.x, n.y); o.y = cvt_pk_bf16(n.z, n.w);
                    ((uint2*)(HN2 + (size_t)row * D))[lane + 64 * j] = o;
#pragma unroll
                    for (int e = 0; e < 4; ++e) { const int c = 4 * (lane + 64 * j) + e; const float hv = n[e];
                        const f32x4 wg = *(const f32x4*)(rgw + (size_t)c * 4);
                        lg[0] += hv * wg.x; lg[1] += hv * wg.y; lg[2] += hv * wg.z; lg[3] += hv * wg.w;
#pragma unroll
                        for (int g = 0; g < 4; ++g) { const f32x4 we = *(const f32x4*)(rew + ((size_t)g * D + c) * 4);
                            lg[4 + g * 4 + 0] += hv * we.x; lg[4 + g * 4 + 1] += hv * we.y; lg[4 + g * 4 + 2] += hv * we.z; lg[4 + g * 4 + 3] += hv * we.w; } } }
#pragma unroll
                for (int o = 0; o < 20; ++o) lg[o] = wave_sum(lg[o]);
                if (lane == 0) { int cls; float wa, wb; route_token(lg, rgb, reb, cls, wa, wb); rcls[tl] = cls; rwa[tl] = wa; rwb[tl] = wb; }
            }
            __syncthreads();
            if (tid < NCLS) { int n = 0; for (int i = 0; i < 128; ++i) n += (rcls[i] == tid) ? 1 : 0; rbase[tid] = n ? (int)atomicAdd(ctl + CW_CNT + 16 * tid, (unsigned)n) : 0; }
            __syncthreads();
            if (tid < 128) { const int cls = rcls[tid]; int lr = 0; for (int i = 0; i < tid; ++i) lr += (rcls[i] == cls) ? 1 : 0; const int rank = rbase[cls] + lr;
                LIST[(size_t)cls * T + rank] = chunk * 128 + tid; WL[((size_t)cls * T + rank) * 2] = rwa[tid]; WL[((size_t)cls * T + rank) * 2 + 1] = rwb[tid]; }
            __syncthreads();
        }
    }
    SEAM(PH_ROUTE);
    if (IN(PH_UP) || IN(PH_DOWN)) {
        if (tid == 0) { int off = 0; for (int c = 0; c < NCLS; ++c) { const int n = (int)ctl[CW_CNT + 16 * c]; ctab[c] = off; ctab[32 + c] = n; off += (n + 255) & ~255; } ctab[NCLS] = off; }
        __syncthreads();
    }
    if (IN(PH_UP)) {
        fill_idx<8>(idx, ctab, LIST, G, bx, wave * 64 + lane_id_fresh());
        SchedUp S{ctab, (const char*)HN2, (const char*)WUP, G, bx};
        EpiUp E{ctab, WL, HID};
        pg8::gemm_phase<EpiUp, SchedUp, true>(lds + RING_OFF, D, D, S, E, idx, wave);
    }
    SEAM(PH_UP);
    if (IN(PH_DOWN)) {
        fill_idx<4>(idx, ctab, LIST, G, bx, wave * 64 + lane_id_fresh());
        SchedDown S{ctab, (const char*)HID, (const char*)WDN, G, bx};
        EpiDown E{idx, H, args.out};
        pg8::gemm_phase<EpiDown, SchedDown, false>(lds + RING_OFF, D, 512, S, E, idx, wave);
    }
    SEAM(PH_DOWN);
    if (IN(PH_FINAL)) {
        const int gw = vcu * 8 + wave, NGW = G * 8;
        for (int m = gw; m < T; m += NGW) { f32x4* xr = (f32x4*)(args.out + (size_t)m * D); f32x4 v[4]; float s = 0.f;
#pragma unroll
            for (int j = 0; j < 4; ++j) { v[j] = xr[lane + 64 * j]; s += (v[j].x * v[j].x + v[j].y * v[j].y) + (v[j].z * v[j].z + v[j].w * v[j].w); }
            const float rstd = rsqrtf(wave_sum(s) * (1.f / D) + EPS);
#pragma unroll
            for (int j = 0; j < 4; ++j) { const f32x4 gv = ((const f32x4*)args.in[19])[lane + 64 * j]; xr[lane + 64 * j] = v[j] * rstd * gv; } }
    }
#undef IN
#undef SEAM
#undef lane
#undef tid
}
static int mk_grid() {
    static int grid = 0;
    if (grid == 0) {
        int dev = 0, cus = 0, per_cu = 0;
        if (hipGetDevice(&dev) != hipSuccess || hipDeviceGetAttribute(&cus, hipDeviceAttributeMultiprocessorCount, dev) != hipSuccess) { grid = -1; return grid; }
        if (hipFuncSetAttribute((const void*)mk_fwd, hipFuncAttributeMaxDynamicSharedMemorySize, LDS_BYTES) != hipSuccess) { fprintf(stderr, "kernel_launch: hipFuncSetAttribute failed\n"); grid = -1; return grid; }
        if (hipOccupancyMaxActiveBlocksPerMultiprocessor(&per_cu, (const void*)mk_fwd, 512, LDS_BYTES) != hipSuccess || per_cu < 1) { fprintf(stderr, "kernel_launch: occupancy query says %d\n", per_cu); }
        (void)hipGetLastError();
        grid = cus;
    }
    return grid;
}
extern "C" void kernel_launch(void* const* d_in, const int* in_sizes, int n_in, void* d_out, int out_size, void* d_ws, size_t ws_size, hipStream_t stream) {
    if (n_in != 20 || out_size != T * D || ws_size < WS_END) { fprintf(stderr, "kernel_launch: unexpected shapes (n_in %d out %d ws %zu)\n", n_in, out_size, ws_size); return; }
    const int grid = mk_grid(); if (grid <= 0) return;
    unsigned char* ws = (unsigned char*)d_ws;
    (void)hipMemsetAsync(ws + WS_CTL, 0, CTL_BYTES, stream);
    MkArgs a{}; for (int i = 0; i < 20; ++i) a.in[i] = (const float*)d_in[i]; a.out = (float*)d_out; a.ws = ws;
    a.ph_lo = PH_PRO; a.ph_hi = PH_N; a.li = 0; hipLaunchKernelGGL(mk_fwd, dim3(grid), dim3(512), LDS_BYTES, stream, a);
}
```

```cpp
#include <hip/hip_runtime.h>
#include <stdint.h>
#include <stdio.h>

typedef unsigned short bf16_t;
typedef short bf16x8 __attribute__((ext_vector_type(8)));
typedef float f32x4 __attribute__((ext_vector_type(4)));
typedef unsigned u32x4 __attribute__((ext_vector_type(4)));

constexpr int T = 32768, D = 1024, SEQ = 4096, NIN = 3840;
constexpr int GMW = 512, AW = 512, KVW = 128, FF = 512, NEXP = 16, NCLS = 24;
constexpr float EPS = 1e-6f;
constexpr float LOG2E = 1.4426950408889634f;

constexpr size_t MiB = 1u << 20;
constexpr size_t WS_CTL = 0, CTL_BYTES = 1 * MiB;
constexpr size_t WS_WIN = 1 * MiB;
constexpr size_t WS_WPA = 9 * MiB;
constexpr size_t WS_WPB = 10 * MiB;
constexpr size_t WS_WOUT = 11 * MiB;
constexpr size_t WS_WUP = 13 * MiB;
constexpr size_t WS_WDN = 45 * MiB;
constexpr size_t WS_WSB = 61 * MiB;
constexpr size_t WS_BIAS = 62 * MiB;
constexpr size_t WS_HN = 64 * MiB;
constexpr size_t WS_U = 128 * MiB, WS_V = 160 * MiB, WS_Q = 192 * MiB, WS_K = 224 * MiB, WS_VV = 232 * MiB;
constexpr size_t WS_GA = 240 * MiB, WS_GB = 304 * MiB;
constexpr size_t WS_A = 368 * MiB, WS_B = 400 * MiB;
constexpr size_t WS_H = 128 * MiB;
constexpr size_t WS_HID = 256 * MiB;
constexpr size_t WS_VSTAT = 432 * MiB;
constexpr size_t WS_LIST = 434 * MiB;
constexpr size_t WS_WL = 437 * MiB;
constexpr size_t WS_HG = 368 * MiB;
constexpr size_t WS_WL4 = 445 * MiB;
constexpr size_t WS_VN = 445 * MiB;
constexpr size_t WS_END = 509 * MiB;
constexpr int CW_CNT = 64;
constexpr int CW_OFF = 1024;

__device__ __forceinline__ float bf2f(bf16_t v) { return __uint_as_float((unsigned)v << 16); }
__device__ __forceinline__ bf16_t f2bf(float f) { unsigned u = __float_as_uint(f); return (bf16_t)((u + 0x7fffu + ((u >> 16) & 1u)) >> 16); }
__device__ __forceinline__ float wave_sum(float v) {
#pragma unroll
    for (int o = 1; o < 64; o <<= 1) v += __shfl_xor(v, o);
    return v;
}
__device__ __forceinline__ float wave_max(float v) {
#pragma unroll
    for (int o = 1; o < 64; o <<= 1) v = fmaxf(v, __shfl_xor(v, o));
    return v;
}
__device__ __forceinline__ float gelu_tanh(float x) {
    const float u = 0.7978845608028654f * (x + 0.044715f * x * x * x);
    const float e = __expf(2.f * u);
    const float th = 1.f - 2.f / (1.f + e);
    return 0.5f * x * (1.f + th);
}
__device__ __forceinline__ float sigmoidf_(float x) { return 1.f / (1.f + __expf(-x)); }

__device__ const unsigned char kBucket[128] = {
    0, 1, 2, 3, 4, 5, 6, 7, 8, 9, 10, 11, 12, 13, 14, 15, 16, 16, 16, 17, 17, 18, 18, 18, 19, 19, 19, 20, 20, 20, 20, 21, 21, 21, 21, 22, 22, 22, 22, 22,
    23, 23, 23, 23, 23, 23, 24, 24, 24, 24, 24, 24, 25, 25, 25, 25, 25, 25, 25, 26, 26, 26, 26, 26, 26, 26, 26, 27, 27, 27, 27, 27, 27, 27, 27, 27, 27,
    28, 28, 28, 28, 28, 28, 28, 28, 28, 28, 29, 29, 29, 29, 29, 29, 29, 29, 29, 29, 29, 29, 30, 30, 30, 30, 30, 30, 30, 30, 30, 30, 30, 30, 30, 30,
    31, 31, 31, 31, 31, 31, 31, 31, 31, 31, 31, 31, 31, 31, 31};

__global__ __launch_bounds__(256) void k_transpose_convert(const float* __restrict__ W, int K, int N, bf16_t* __restrict__ WT, int ldk, int row_off, int blk, int blk_stride) {
    __shared__ float tile[32][33];
    const int n0 = blockIdx.x * 32, k0 = blockIdx.y * 32, tx = threadIdx.x & 31, ty = threadIdx.x >> 5;
    for (int i = ty; i < 32; i += 8) tile[i][tx] = W[(size_t)(k0 + i) * N + n0 + tx];
    __syncthreads();
    for (int i = ty; i < 32; i += 8) { const int n = n0 + i; const int row = row_off + (n / blk) * blk_stride + (n % blk);
        WT[(size_t)row * ldk + k0 + tx] = f2bf(tile[tx][i]); }
}
__global__ __launch_bounds__(256) void k_small_tables(const float* __restrict__ ws_in, const float* __restrict__ rel_bias, bf16_t* __restrict__ wsb, float* __restrict__ biasT) {
    const int i = blockIdx.x * 256 + threadIdx.x;
    if (i < 8 * 128 * 128) { const int s = i & 127, t = (i >> 7) & 127; wsb[i] = (s <= t) ? f2bf(ws_in[i]) : (bf16_t)0; }
    if (i < 8 * 128) { const int h = i >> 7, dist = i & 127; biasT[i] = rel_bias[kBucket[dist] * 8 + h] * LOG2E; }
}
__global__ __launch_bounds__(256) void k_rmsnorm_bf16(const float* __restrict__ x, const float* __restrict__ g, bf16_t* __restrict__ out) {
    const int row = blockIdx.x * 4 + (threadIdx.x >> 6), lane = threadIdx.x & 63;
    const f32x4* xr = (const f32x4*)(x + (size_t)row * D);
    f32x4 v[4]; float s = 0.f;
#pragma unroll
    for (int j = 0; j < 4; ++j) { v[j] = xr[lane + 64 * j]; s += v[j].x * v[j].x + v[j].y * v[j].y + v[j].z * v[j].z + v[j].w * v[j].w; }
    const float rstd = rsqrtf(wave_sum(s) * (1.f / D) + EPS);
#pragma unroll
    for (int j = 0; j < 4; ++j) { const f32x4 gv = ((const f32x4*)g)[lane + 64 * j];
        ushort4 o; o.x = f2bf(v[j].x * rstd * gv.x); o.y = f2bf(v[j].y * rstd * gv.y); o.z = f2bf(v[j].z * rstd * gv.z); o.w = f2bf(v[j].w * rstd * gv.w);
        ((ushort4*)(out + (size_t)row * D))[lane + 64 * j] = o; }
}

template <int MODE, class Op>
__global__ __launch_bounds__(256) void k_gemm_simple(Op op) {
    if (!op.active()) return;
    const int wave = threadIdx.x >> 6, lane = threadIdx.x & 63, wy = wave >> 1, wx = wave & 1, fr = lane & 15, fq = lane >> 4;
    const int row0 = blockIdx.y * 64 + wy * 32, col0 = blockIdx.x * 64 + wx * 32;
    f32x4 acc[2][2][2];
#pragma unroll
    for (int s = 0; s < 2; ++s)
#pragma unroll
        for (int i = 0; i < 2; ++i)
#pragma unroll
            for (int j = 0; j < 2; ++j) acc[s][i][j] = (f32x4){0.f, 0.f, 0.f, 0.f};
#pragma unroll
    for (int seg = 0; seg < (MODE == 0 ? 1 : 2); ++seg) {
        const bf16_t* ap[2]; const bf16_t* bp[2];
#pragma unroll
        for (int i = 0; i < 2; ++i) { ap[i] = op.arow(seg, row0 + i * 16 + fr) + fq * 8; bp[i] = op.brow(seg, col0 + i * 16 + fr) + fq * 8; }
        const int K = op.K(seg);
        for (int k = 0; k < K; k += 32) {
            bf16x8 a[2], b[2];
#pragma unroll
            for (int i = 0; i < 2; ++i) { a[i] = *(const bf16x8*)(ap[i] + k); b[i] = *(const bf16x8*)(bp[i] + k); }
#pragma unroll
            for (int i = 0; i < 2; ++i)
#pragma unroll
                for (int j = 0; j < 2; ++j) {
                    if (MODE == 2 && seg == 1) acc[1][i][j] = __builtin_amdgcn_mfma_f32_16x16x32_bf16(a[i], b[j], acc[1][i][j], 0, 0, 0);
                    else acc[0][i][j] = __builtin_amdgcn_mfma_f32_16x16x32_bf16(a[i], b[j], acc[0][i][j], 0, 0, 0);
                }
        }
    }
#pragma unroll
    for (int i = 0; i < 2; ++i)
#pragma unroll
        for (int j = 0; j < 2; ++j)
#pragma unroll
            for (int r = 0; r < 4; ++r) op.epi(row0 + i * 16 + fq * 4 + r, col0 + j * 16 + fr, acc[0][i][j][r], acc[1][i][j][r]);
}

struct OpG1 {
    const bf16_t* hn; const bf16_t* wt; bf16_t *U, *V, *Q, *Kb, *VV, *GA, *GB;
    __device__ bool active() const { return true; }
    __device__ int K(int) const { return D; }
    __device__ const bf16_t* arow(int, int r) const { return hn + (size_t)r * D; }
    __device__ const bf16_t* brow(int, int c) const { return wt + (size_t)c * D; }
    __device__ void epi(int r, int c, float v, float) const {
        if (c < 512) U[(size_t)r * 512 + c] = f2bf(gelu_tanh(v));
        else if (c < 1024) V[(size_t)r * 512 + (c - 512)] = f2bf(gelu_tanh(v));
        else if (c < 1536) Q[(size_t)r * 512 + (c - 1024)] = f2bf(v * (0.125f * LOG2E));
        else if (c < 1664) Kb[(size_t)r * 128 + (c - 1536)] = f2bf(v);
        else if (c < 1792) VV[(size_t)r * 128 + (c - 1664)] = f2bf(v);
        else if (c < 2816) GA[(size_t)r * 1024 + (c - 1792)] = f2bf(sigmoidf_(v));
        else GB[(size_t)r * 1024 + (c - 2816)] = f2bf(sigmoidf_(v));
    }
};
__global__ __launch_bounds__(256) void k_vstat_simple(const bf16_t* __restrict__ V, float* __restrict__ vstat) {
    const int row = blockIdx.x * 4 + (threadIdx.x >> 6), lane = threadIdx.x & 63;
    float s = 0.f, q = 0.f;
    for (int j = 0; j < 8; ++j) { const float v = bf2f(V[(size_t)row * 512 + lane + 64 * j]); s += v; q += v * v; }
    s = wave_sum(s); q = wave_sum(q);
    if (lane < 16) vstat[(size_t)row * 16 + lane] = lane == 0 ? s : (lane == 1 ? q : 0.f);
}
__global__ __launch_bounds__(256) void k_vnorm_simple(const bf16_t* __restrict__ V, const float* __restrict__ vstat, const float* __restrict__ gv, float* __restrict__ vn) {
    const int row = blockIdx.x * 4 + (threadIdx.x >> 6), lane = threadIdx.x & 63;
    float s = 0.f, q = 0.f;
    for (int p = 0; p < 8; ++p) { s += vstat[(size_t)row * 16 + 2 * p]; q += vstat[(size_t)row * 16 + 2 * p + 1]; }
    const float mean = s * (1.f / 512.f), var = fmaxf(q * (1.f / 512.f) - mean * mean, 0.f), rstd = rsqrtf(var + EPS);
    for (int j = 0; j < 8; ++j) { const int c = lane + 64 * j; vn[(size_t)row * 512 + c] = (bf2f(V[(size_t)row * 512 + c]) - mean) * rstd * gv[c]; }
}
__global__ __launch_bounds__(256) void k_gmlp_simple(const bf16_t* __restrict__ U, const float* __restrict__ vn, const bf16_t* __restrict__ wsb, const float* __restrict__ bs, bf16_t* __restrict__ A) {
    const int t = blockIdx.x, tl = t & 127, c0 = t - tl;
    for (int ch = threadIdx.x; ch < 512; ch += 256) {
        const int g = ch >> 6; float acc = 0.f;
        for (int s = 0; s <= tl; ++s) acc += bf2f(wsb[(g * 128 + tl) * 128 + s]) * vn[(size_t)(c0 + s) * 512 + ch];
        const float sv = acc + bs[g * 128 + tl];
        A[(size_t)t * 512 + ch] = f2bf(bf2f(U[(size_t)t * 512 + ch]) * sv);
    }
}
__global__ __launch_bounds__(256) void k_attn_simple(const bf16_t* __restrict__ Q, const bf16_t* __restrict__ Kb, const bf16_t* __restrict__ VV, const float* __restrict__ biasT,
                                                     const float* __restrict__ sinks, bf16_t* __restrict__ B) {
    const int w = blockIdx.x * 4 + (threadIdx.x >> 6), lane = threadIdx.x & 63;
    const int t = w >> 3, h = w & 7, kh = h >> 2, pos = t & (SEQ - 1), bb = t - pos;
    float sc[2]; float m = sinks[h] * LOG2E; const float sink2 = m;
#pragma unroll
    for (int u = 0; u < 2; ++u) {
        const int j = lane + 64 * u, kpos = pos - 127 + j, dist = 127 - j;
        float s = -1e30f;
        if (kpos >= 0) { float a = 0.f; const bf16_t* qp = Q + (size_t)t * 512 + h * 64; const bf16_t* kp = Kb + (size_t)(bb + kpos) * 128 + kh * 64;
            for (int d = 0; d < 64; ++d) a += bf2f(qp[d]) * bf2f(kp[d]);
            s = a + biasT[h * 128 + dist]; }
        sc[u] = s; m = fmaxf(m, s);
    }
    m = wave_max(m);
    float p0 = exp2f(sc[0] - m), p1 = exp2f(sc[1] - m);
    const float denom = wave_sum(p0 + p1) + exp2f(sink2 - m);
    p0 /= denom; p1 /= denom;
    float o = 0.f;
    for (int j = 0; j < 128; ++j) { const float p = __shfl(j < 64 ? p0 : p1, j & 63); const int kpos = pos - 127 + j;
        if (kpos >= 0) o += p * bf2f(VV[(size_t)(bb + kpos) * 128 + kh * 64 + lane]); }
    B[(size_t)t * 512 + h * 64 + lane] = f2bf(o);
}
struct OpG3 {
    const bf16_t *A, *B, *wpa, *wpb, *GA, *GB; bf16_t* M;
    __device__ bool active() const { return true; }
    __device__ int K(int) const { return 512; }
    __device__ const bf16_t* arow(int s, int r) const { return (s ? B : A) + (size_t)r * 512; }
    __device__ const bf16_t* brow(int s, int c) const { return (s ? wpb : wpa) + (size_t)c * 512; }
    __device__ void epi(int r, int c, float v1, float v2) const { const size_t i = (size_t)r * D + c; M[i] = f2bf(bf2f(GA[i]) * v1 + bf2f(GB[i]) * v2); }
};
struct OpG4 {
    const bf16_t *M, *wt; const float* x; float* H;
    __device__ bool active() const { return true; }
    __device__ int K(int) const { return D; }
    __device__ const bf16_t* arow(int, int r) const { return M + (size_t)r * D; }
    __device__ const bf16_t* brow(int, int c) const { return wt + (size_t)c * D; }
    __device__ void epi(int r, int c, float v, float) const { const size_t i = (size_t)r * D + c; H[i] = x[i] + v; }
};
__device__ __forceinline__ void route_token(const float (&lg)[20], const float* __restrict__ rgb, const float* __restrict__ reb, int& cls, float& wa, float& wb) {
    float gl[4]; float gm = -1e30f; int gi = 0;
#pragma unroll
    for (int i = 0; i < 4; ++i) { gl[i] = lg[i] + rgb[i]; if (gl[i] > gm) { gm = gl[i]; gi = i; } }
    float gs = 0.f;
#pragma unroll
    for (int i = 0; i < 4; ++i) gs += __expf(gl[i] - gm);
    const float gp = 1.f / gs;
    float el[4];
#pragma unroll
    for (int i = 0; i < 4; ++i) { float v = 0.f;
#pragma unroll
        for (int g = 0; g < 4; ++g) v = (g == gi) ? lg[4 + g * 4 + i] + reb[g * 4 + i] : v;
        el[i] = v; }
    int i1 = 0; float v1 = el[0];
#pragma unroll
    for (int i = 1; i < 4; ++i) if (el[i] > v1) { v1 = el[i]; i1 = i; }
    int i2 = -1; float v2 = -1e30f;
#pragma unroll
    for (int i = 0; i < 4; ++i) if (i != i1 && (i2 < 0 || el[i] > v2)) { v2 = el[i]; i2 = i; }
    const float e2 = __expf(v2 - v1), w1 = gp / (1.f + e2), w2 = gp * e2 / (1.f + e2);
    const int a = i1 < i2 ? i1 : i2, b = i1 < i2 ? i2 : i1;
    const int pi = (a == 0) ? (b - 1) : ((a == 1) ? (b + 1) : 5);
    cls = gi * 6 + pi; wa = (i1 < i2) ? w1 : w2; wb = (i1 < i2) ? w2 : w1;
}
__global__ __launch_bounds__(256) void k_router_simple(const float* __restrict__ H, const float* __restrict__ g2, const float* __restrict__ rgw, const float* __restrict__ rgb,
                                                       const float* __restrict__ rew, const float* __restrict__ reb, bf16_t* __restrict__ HN2, unsigned* __restrict__ ctl,
                                                       int* __restrict__ list, float* __restrict__ wl) {
    const int row = blockIdx.x * 4 + (threadIdx.x >> 6), lane = threadIdx.x & 63;
    const f32x4* xr = (const f32x4*)(H + (size_t)row * D);
    f32x4 v[4]; float s = 0.f;
#pragma unroll
    for (int j = 0; j < 4; ++j) { v[j] = xr[lane + 64 * j]; s += v[j].x * v[j].x + v[j].y * v[j].y + v[j].z * v[j].z + v[j].w * v[j].w; }
    const float rstd = rsqrtf(wave_sum(s) * (1.f / D) + EPS);
    float lg[20];
#pragma unroll
    for (int o = 0; o < 20; ++o) lg[o] = 0.f;
#pragma unroll
    for (int j = 0; j < 4; ++j) { const f32x4 gv = ((const f32x4*)g2)[lane + 64 * j];
        f32x4 n; n.x = v[j].x * rstd * gv.x; n.y = v[j].y * rstd * gv.y; n.z = v[j].z * rstd * gv.z; n.w = v[j].w * rstd * gv.w;
        ushort4 o; o.x = f2bf(n.x); o.y = f2bf(n.y); o.z = f2bf(n.z); o.w = f2bf(n.w);
        ((ushort4*)(HN2 + (size_t)row * D))[lane + 64 * j] = o;
#pragma unroll
        for (int e = 0; e < 4; ++e) { const int c = 4 * (lane + 64 * j) + e; const float hv = n[e];
            const f32x4 wg = *(const f32x4*)(rgw + (size_t)c * 4);
            lg[0] += hv * wg.x; lg[1] += hv * wg.y; lg[2] += hv * wg.z; lg[3] += hv * wg.w;
#pragma unroll
            for (int g = 0; g < 4; ++g) { const f32x4 we = *(const f32x4*)(rew + ((size_t)g * D + c) * 4);
                lg[4 + g * 4 + 0] += hv * we.x; lg[4 + g * 4 + 1] += hv * we.y; lg[4 + g * 4 + 2] += hv * we.z; lg[4 + g * 4 + 3] += hv * we.w; } } }
#pragma unroll
    for (int o = 0; o < 20; ++o) lg[o] = wave_sum(lg[o]);
    if (lane == 0) { int cls; float wa, wb; route_token(lg, rgb, reb, cls, wa, wb);
        const unsigned rank = atomicAdd(ctl + CW_CNT + 16 * cls, 1u);
        list[(size_t)cls * T + rank] = row; wl[((size_t)cls * T + rank) * 2] = wa; wl[((size_t)cls * T + rank) * 2 + 1] = wb; }
}
__global__ void k_class_offsets(unsigned* ctl) {
    if (threadIdx.x == 0 && blockIdx.x == 0) { unsigned off = 0; for (int c = 0; c < NCLS; ++c) { ctl[CW_OFF + c] = off; off += (ctl[CW_CNT + 16 * c] + 255u) & ~255u; } ctl[CW_OFF + NCLS] = off; }
}
__device__ __forceinline__ void class_experts(int cls, int& e1, int& e2) {
    const int g = cls / 6, pi = cls % 6; const int a = pi < 3 ? 0 : (pi < 5 ? 1 : 2); const int b = pi < 3 ? pi + 1 : (pi < 5 ? pi - 1 : 3);
    e1 = 4 * g + a; e2 = 4 * g + b;
}
struct OpUp {
    const bf16_t *HN2, *wup; const unsigned* ctl; const int* list; const float* wl; bf16_t* HID;
    __device__ bool active() const { return blockIdx.y * 64u < ctl[CW_CNT + 16 * blockIdx.z]; }
    __device__ int K(int) const { return D; }
    __device__ const bf16_t* arow(int, int r) const { const int cls = blockIdx.z; const unsigned cnt = ctl[CW_CNT + 16 * cls]; const int t = (unsigned)r < cnt ? list[(size_t)cls * T + r] : 0; return HN2 + (size_t)t * D; }
    __device__ const bf16_t* brow(int s, int c) const { int e1, e2; class_experts(blockIdx.z, e1, e2); const int e = c < 512 ? e1 : e2, hc = c & 511;
        return wup + ((size_t)e * 1024 + (hc >> 7) * 256 + s * 128 + (hc & 127)) * D; }
    __device__ void epi(int r, int c, float g, float u) const { const int cls = blockIdx.z; const unsigned cnt = ctl[CW_CNT + 16 * cls];
        if ((unsigned)r < cnt) { const float w = wl[((size_t)cls * T + r) * 2 + (c >> 9)]; HID[((size_t)ctl[CW_OFF + cls] + r) * 1024 + c] = f2bf(w * (g / (1.f + __expf(-g))) * u); } }
};
struct OpDown {
    const bf16_t *HID, *wdn; const unsigned* ctl; const int* list; const float* H; float* OUT;
    __device__ bool active() const { return blockIdx.y * 64u < ctl[CW_CNT + 16 * blockIdx.z]; }
    __device__ int K(int) const { return 512; }
    __device__ const bf16_t* arow(int s, int r) const { return HID + ((size_t)ctl[CW_OFF + blockIdx.z] + r) * 1024 + s * 512; }
    __device__ const bf16_t* brow(int s, int c) const { int e1, e2; class_experts(blockIdx.z, e1, e2); return wdn + ((size_t)(s ? e2 : e1) * 1024 + c) * 512; }
    __device__ void epi(int r, int c, float v, float) const { const int cls = blockIdx.z; const unsigned cnt = ctl[CW_CNT + 16 * cls];
        if ((unsigned)r < cnt) { const int t = list[(size_t)cls * T + r]; const size_t i = (size_t)t * D + c; OUT[i] = H[i] + v; } }
};
__global__ __launch_bounds__(256) void k_final_norm(float* __restrict__ out, const float* __restrict__ g) {
    const int row = blockIdx.x * 4 + (threadIdx.x >> 6), lane = threadIdx.x & 63;
    f32x4* xr = (f32x4*)(out + (size_t)row * D);
    f32x4 v[4]; float s = 0.f;
#pragma unroll
    for (int j = 0; j < 4; ++j) { v[j] = xr[lane + 64 * j]; s += v[j].x * v[j].x + v[j].y * v[j].y + v[j].z * v[j].z + v[j].w * v[j].w; }
    const float rstd = rsqrtf(wave_sum(s) * (1.f / D) + EPS);
#pragma unroll
    for (int j = 0; j < 4; ++j) { const f32x4 gv = ((const f32x4*)g)[lane + 64 * j]; f32x4 o; o.x = v[j].x * rstd * gv.x; o.y = v[j].y * rstd * gv.y; o.z = v[j].z * rstd * gv.z; o.w = v[j].w * rstd * gv.w; xr[lane + 64 * j] = o; }
}


#define LAS __attribute__((address_space(3)))
#define GAS __attribute__((address_space(1)))
typedef GAS unsigned gu32;
#define RLX_AGENT __ATOMIC_RELAXED, __HIP_MEMORY_SCOPE_AGENT
#define LDS_WAIT() asm volatile("s_waitcnt lgkmcnt(0)" ::: "memory")
#define VM_WAIT() asm volatile("s_waitcnt vmcnt(0)" ::: "memory")

#define XB_TMO      128
#define XB_XCNT(j)  (256  + 64 * (j))
#define XB_XSUB(j)  (1280 + 64 * (j))
#define XB_XGEN(j)  (2304 + 64 * (j))
#define XB_TOP      3328
#define XB_TOPGEN   3392
#define XCD_BAR_WORDS 3456
#define XB_SPIN_CAP (1u << 18)
__device__ __forceinline__ unsigned xb_ld(unsigned* p)              { return __hip_atomic_load(p, __ATOMIC_RELAXED, __HIP_MEMORY_SCOPE_AGENT); }
__device__ __forceinline__ unsigned xb_add(unsigned* p, unsigned v) { return __hip_atomic_fetch_add(p, v, __ATOMIC_RELAXED, __HIP_MEMORY_SCOPE_AGENT); }
__device__ __forceinline__ unsigned xb_xcc_id() { return (unsigned)__builtin_amdgcn_s_getreg((3 << 11) | 20) & 0xFu; }
#define XB_SPIN(cond, bar) do { unsigned _sp = 0; while (cond) { __builtin_amdgcn_s_sleep(1); \
    if ((++_sp & 255u) == 0u) { if (xb_ld(&(bar)[XB_TMO])) break; if (_sp > XB_SPIN_CAP) { atomicAdd(&(bar)[XB_TMO], 1u); break; } } } } while (0)
struct XcdBarrier { unsigned* bar; unsigned x; volatile LAS unsigned* st; };
__device__ __forceinline__ XcdBarrier xcd_barrier_post(unsigned* bar, volatile LAS unsigned* st) {
    XcdBarrier b; b.bar = bar; b.x = xb_xcc_id(); b.st = st;
    if (threadIdx.x == 0) (void)xb_add(&bar[XB_XCNT(b.x)], 1u);
    return b;
}
__device__ __forceinline__ void xcd_barrier_complete(unsigned* bar, unsigned x, unsigned& nloc, unsigned& nx) {
    const unsigned G = gridDim.x * gridDim.y * gridDim.z;
    unsigned sum, cnt, mine, sp = 0u;
    for (;;) {
        sum = 0u; cnt = 0u; mine = 0u;
#pragma unroll
        for (unsigned j = 0; j < 16; ++j) { const unsigned c = xb_ld(&bar[XB_XCNT(j)]); sum += c; cnt += (c > 0u) ? 1u : 0u; mine = (j == x) ? c : mine; }
        if (sum == G) break;
        __builtin_amdgcn_s_sleep(1);
        if ((++sp & 255u) == 0u) { if (xb_ld(&bar[XB_TMO])) break; if (sp > XB_SPIN_CAP) { atomicAdd(&bar[XB_TMO], 1u); break; } }
    }
    nloc = mine > 0u ? mine : 1u; nx = cnt > 0u ? cnt : 1u;
}
__device__ __forceinline__ void xcd_barrier(const XcdBarrier& b) {
    asm volatile("s_waitcnt vmcnt(0)" ::: "memory");
    __syncthreads();
    if (threadIdx.x == 0) {
        unsigned* bar = b.bar;
        __builtin_amdgcn_s_waitcnt(0);
        unsigned nloc = b.st[0], nx = b.st[1];
        if (nloc == 0u) { xcd_barrier_complete(bar, b.x, nloc, nx); b.st[0] = nloc; b.st[1] = nx; }
        const unsigned old = xb_add(&bar[XB_XSUB(b.x)], 1u);
        const unsigned gen = old / nloc;
        if (old + 1u == (gen + 1u) * nloc) {
            __builtin_amdgcn_fence(__ATOMIC_RELEASE, "agent");
            asm volatile("s_waitcnt vmcnt(0)" ::: "memory");
            const unsigned og = xb_add(&bar[XB_TOP], 1u);
            const unsigned tg = og / nx;
            if (og + 1u == (tg + 1u) * nx) xb_add(&bar[XB_TOPGEN], 1u);
            else XB_SPIN(xb_ld(&bar[XB_TOPGEN]) == tg, bar);
            __builtin_amdgcn_fence(__ATOMIC_ACQUIRE, "agent");
            xb_add(&bar[XB_XGEN(b.x)], 1u);
            asm volatile("s_waitcnt vmcnt(0)" ::: "memory");
        } else {
            XB_SPIN(xb_ld(&bar[XB_XGEN(b.x)]) == gen, bar);
            __builtin_amdgcn_fence(__ATOMIC_ACQUIRE, "agent");
            asm volatile("s_waitcnt vmcnt(0)" ::: "memory");
        }
    }
    __syncthreads();
}

__device__ __forceinline__ int lane_id_fresh() { int l = (int)__builtin_amdgcn_mbcnt_hi(~0u, __builtin_amdgcn_mbcnt_lo(~0u, 0u)); asm volatile("" : "+v"(l)); return l; }
constexpr int RING_OFF = 0, RING_BYTES = 131072;
constexpr int LDSCTL_OFF = RING_BYTES;
constexpr int CTAB_OFF = LDSCTL_OFF + 512;
constexpr int IDX_OFF = LDSCTL_OFF + 1024;
constexpr int LG_OFF = IDX_OFF;
constexpr int RSC_OFF = LG_OFF + 16384;
constexpr int LDS_BYTES = 151552;
constexpr int CW_BAR = 4096;

__device__ __forceinline__ unsigned cvt_pk_bf16(float lo, float hi) { unsigned r; asm volatile("v_cvt_pk_bf16_f32 %0, %1, %2" : "=v"(r) : "v"(lo), "v"(hi)); return r; }
__device__ __forceinline__ float fast_sigmoid(float x) { return __builtin_amdgcn_rcpf(1.f + __builtin_amdgcn_exp2f(-LOG2E * x)); }
__device__ __forceinline__ float fast_gelu(float x) {
    const float t = x * (-2.f * LOG2E * 0.7978845608028654f) * (1.f + 0.044715f * x * x);
    return x * __builtin_amdgcn_rcpf(1.f + __builtin_amdgcn_exp2f(t));
}

namespace pg8 {
constexpr int BM = 256, BK = 64, HALF = 128, HTB = HALF * BK * 2, STAGE_BYTES = 8 * HTB, NXCD = 8, WGM = 8;
__host__ __device__ __forceinline__ int lds_byte(int r, int c) { const int st = (r >> 4) * 2 + (c >> 5), rr = r & 15, cc = c & 31, ob = rr * 64 + cc * 2; return st * 1024 + (ob ^ (((ob >> 9) & 1) << 5)); }
__host__ __device__ __forceinline__ void stage_rc(int b, int& R, int& C) { const int st = b / 1024, sb = b % 1024, swz = sb ^ (((sb >> 9) & 1) << 5); R = (st >> 1) * 16 + swz / 64; C = (st & 1) * 32 + (swz % 64) / 2; }
__host__ __device__ __forceinline__ int perm32(int rho) { const int n = rho >> 4, i = rho & 15; return 8 * (i >> 2) + 4 * n + (i & 3); }

struct Unit { const char* A; const char* B0; const char* B1p; int pm, pn, aux, slot; };

struct TileOrder {
    int nM, nN, nwg, G, c;
    __device__ void init(int M, int N, int G_, int c_) { nM = M / BM; nN = N / BM; nwg = nM * nN; G = G_; c = c_; }
    __device__ bool tile(int i, int& pm, int& pn) const {
        const long L = (long)i * G + c; if (L >= nwg) return false;
        int wgid = (int)L; { const int q = nwg / NXCD, r = nwg % NXCD, xcd = wgid % NXCD, off = wgid / NXCD; wgid = (xcd < r ? xcd * (q + 1) : r * (q + 1) + (xcd - r) * q) + off; }
        const int nig = WGM * nN, gid = wgid / nig, fm = gid * WGM, gsz = (nM - fm) < WGM ? (nM - fm) : WGM;
        pm = fm + ((wgid % nig) % gsz); pn = (wgid % nig) / gsz; return true;
    }
};

template <class Epi, class Sched, bool GATHER>
__device__ __forceinline__ void gemm_phase(LAS unsigned char* lds, const int K, const int ldb, const Sched& S, const Epi& E, const LAS int* idx, const int wid) {
    const int lane = lane_id_fresh(), tid = wid * 64 + lane, wr = wid >> 2, wc = wid & 3, fr = lane & 15, fq = lane >> 4;
    const int nt = K / BK, halfk = nt / 2;
    int RA[2], CA[2]; unsigned voffB[2];
#pragma unroll
    for (int i = 0; i < 2; ++i) { int R, C; stage_rc(tid * 16 + i * 8192, R, C); RA[i] = R; CA[i] = C; const int Rb = Epi::PERM ? ((R & ~31) + perm32(R & 31)) : R;
        voffB[i] = (unsigned)(Rb * ldb + C) * 2u; }
    const size_t kstep = (size_t)(BK * 2);
    const size_t hstepB = (size_t)HALF * ldb * 2;
    const unsigned ldsw = (unsigned)wid * 1024u;
    const int aoff = lds_byte(wr * 64 + fr, fq * 8), boff = lds_byte(wc * 32 + fr, fq * 8);
#define PG8_SA(b, h) (((b) * 2 + (h)) * HTB)
#define PG8_SB(b, h) ((4 + (b) * 2 + (h)) * HTB)
#define PG8_STAGE(bufoff, gbase, voff) do { _Pragma("unroll") for (int _i = 0; _i < 2; ++_i) \
        __builtin_amdgcn_global_load_lds((const unsigned*)((const char*)(gbase) + (voff)[_i]), (LAS unsigned*)(lds + (bufoff) + ldsw + _i * 8192), 16, 0, 0); } while (0)
#define PG8_LDA(dst, b, h) do { _Pragma("unroll") for (int m = 0; m < 4; ++m) _Pragma("unroll") for (int k = 0; k < 2; ++k) dst[m][k] = *(const LAS bf16x8*)(lds + PG8_SA(b, h) + aoff + m * 2048 + k * 1024); } while (0)
#define PG8_LDB(dst, b, h) do { _Pragma("unroll") for (int n = 0; n < 2; ++n) _Pragma("unroll") for (int k = 0; k < 2; ++k) dst[n][k] = *(const LAS bf16x8*)(lds + PG8_SB(b, h) + boff + n * 2048 + k * 1024); } while (0)
#define PG8_MMA(ai, bj, At, Bt) do { __builtin_amdgcn_s_setprio(1); _Pragma("unroll") for (int m = 0; m < 4; ++m) _Pragma("unroll") for (int n = 0; n < 2; ++n) _Pragma("unroll") for (int k = 0; k < 2; ++k) \
        acc[ai][bj][m][n] = __builtin_amdgcn_mfma_f32_16x16x32_bf16(Bt[n][k], At[m][k], acc[ai][bj][m][n], 0, 0, 0); __builtin_amdgcn_s_setprio(0); } while (0)
#define PG8_WAIT_V(n) asm volatile("s_waitcnt vmcnt(" #n ")" ::: "memory")
#define PG8_WAIT_L(n) asm volatile("s_waitcnt lgkmcnt(" #n ")" ::: "memory")
#define PG8_BAR __builtin_amdgcn_s_barrier()
#define PG8_SCHED __builtin_amdgcn_sched_barrier(0)
#define PG8_SETVA(va, slot_) do { _Pragma("unroll") for (int _h = 0; _h < 2; ++_h) _Pragma("unroll") for (int _i = 0; _i < 2; ++_i) { \
        if (GATHER) (va)[_h][_i] = (unsigned)(idx[(slot_) * 256 + _h * 128 + RA[_i]] & 0x7fffffff) * (unsigned)(K * 2) + (unsigned)(CA[_i] * 2); \
        else (va)[_h][_i] = (unsigned)((_h * 128 + RA[_i]) * K + CA[_i]) * 2u; } } while (0)
    Unit cur, nxt; int ui = 0;
    if (!S.next(0, cur)) return;
    f32x4 acc[2][2][4][2];
#pragma unroll
    for (int a = 0; a < 2; ++a)
#pragma unroll
        for (int b = 0; b < 2; ++b)
#pragma unroll
            for (int m = 0; m < 4; ++m)
#pragma unroll
                for (int n = 0; n < 2; ++n) acc[a][b][m][n] = (f32x4){0.f, 0.f, 0.f, 0.f};
    bf16x8 At[4][2], B0[2][2], B1[2][2];
    unsigned cva[2][2], nva[2][2];
    PG8_SETVA(cva, cur.slot);
    PG8_STAGE(PG8_SB(0, 0), cur.B0, voffB); PG8_STAGE(PG8_SB(0, 1), cur.B0 + hstepB, voffB); PG8_STAGE(PG8_SA(0, 0), cur.A, cva[0]); PG8_STAGE(PG8_SA(0, 1), cur.A, cva[1]);
    if (wr == 1) PG8_BAR;
    PG8_WAIT_V(2); PG8_BAR;
    PG8_STAGE(PG8_SB(1, 0), cur.B0 + kstep, voffB); PG8_STAGE(PG8_SA(1, 0), cur.A + kstep, cva[0]); PG8_STAGE(PG8_SB(1, 1), cur.B0 + hstepB + kstep, voffB);
    PG8_WAIT_V(6); PG8_BAR;
    for (;;) {
        const bool has_next = S.next(ui + 1, nxt);
        if (!has_next) { nxt.A = cur.A; nxt.B0 = cur.B0; nxt.B1p = cur.B1p; nxt.slot = cur.slot; }
        if (GATHER) { PG8_SETVA(nva, nxt.slot); }
        for (int t = 0; t < nt; t += 2) {
            const bool last = (t == nt - 2);
            const char* a1 = cur.A + (size_t)(t + 1) * kstep;
            const char* a2 = last ? nxt.A : cur.A + (size_t)(t + 2) * kstep;
            const char* b2 = last ? nxt.B0 : ((t + 2 < halfk) ? cur.B0 : cur.B1p) + (size_t)(t + 2) * kstep;
            const char* a3 = a2 + kstep; const char* b3 = b2 + kstep;
            unsigned v20[2], v21[2];
#pragma unroll
            for (int i = 0; i < 2; ++i) { v20[i] = (GATHER && last) ? nva[0][i] : cva[0][i]; v21[i] = (GATHER && last) ? nva[1][i] : cva[1][i]; }
            PG8_LDB(B0, 0, 0); PG8_LDB(B1, 0, 1); PG8_SCHED; PG8_LDA(At, 0, 0); PG8_STAGE(PG8_SA(1, 1), a1, cva[1]);
            PG8_WAIT_V(8); PG8_WAIT_L(0); PG8_BAR; PG8_MMA(0, 0, At, B0); PG8_MMA(0, 1, At, B1); PG8_BAR; PG8_SCHED;
            PG8_LDA(At, 0, 1); PG8_STAGE(PG8_SB(0, 0), b2, voffB); PG8_STAGE(PG8_SB(0, 1), b2 + hstepB, voffB); PG8_STAGE(PG8_SA(0, 0), a2, v20);
            PG8_WAIT_V(8); PG8_WAIT_L(0); PG8_BAR; PG8_MMA(1, 0, At, B0); PG8_MMA(1, 1, At, B1); PG8_BAR; PG8_SCHED;
            PG8_LDB(B0, 1, 0); PG8_LDB(B1, 1, 1); PG8_SCHED; PG8_LDA(At, 1, 0); PG8_STAGE(PG8_SA(0, 1), a2, v21);
            PG8_WAIT_V(8); PG8_WAIT_L(0); PG8_BAR; PG8_MMA(0, 0, At, B0); PG8_MMA(0, 1, At, B1); PG8_BAR; PG8_SCHED;
            PG8_LDA(At, 1, 1); PG8_STAGE(PG8_SB(1, 0), b3, voffB); PG8_STAGE(PG8_SB(1, 1), b3 + hstepB, voffB); PG8_STAGE(PG8_SA(1, 0), a3, v20);
            PG8_WAIT_V(8); PG8_WAIT_L(0); PG8_BAR; PG8_MMA(1, 0, At, B0); PG8_MMA(1, 1, At, B1); PG8_BAR; PG8_SCHED;
        }
        if (wr == 0) PG8_BAR;
        { int fr_e = fr, fq_e = fq; asm volatile("" : "+v"(fr_e), "+v"(fq_e)); E(acc, cur, wr, wc, fr_e, fq_e); }
        if (!has_next) break;
        if (!E.keep_acc(cur)) {
#pragma unroll
            for (int a = 0; a < 2; ++a)
#pragma unroll
                for (int b = 0; b < 2; ++b)
#pragma unroll
                    for (int m = 0; m < 4; ++m)
#pragma unroll
                        for (int n = 0; n < 2; ++n) acc[a][b][m][n] = (f32x4){0.f, 0.f, 0.f, 0.f};
        }
        cur = nxt; ++ui;
        if (GATHER) {
#pragma unroll
            for (int h = 0; h < 2; ++h)
#pragma unroll
                for (int i = 0; i < 2; ++i) cva[h][i] = nva[h][i];
        }
        if (wr == 1) PG8_BAR;
    }
    PG8_WAIT_V(0);
    PG8_BAR;
#undef PG8_SA
#undef PG8_SB
#undef PG8_STAGE
#undef PG8_LDA
#undef PG8_LDB
#undef PG8_MMA
#undef PG8_WAIT_V
#undef PG8_WAIT_L
#undef PG8_BAR
#undef PG8_SCHED
#undef PG8_SETVA
}
}

struct MkArgs {
    const float* in[20]; float* out; unsigned char* ws; int ph_lo, ph_hi, li, pad;
};
enum { PH_PRO = 0, PH_G1 = 1, PH_MIX = 2, PH_G3 = 3, PH_G4 = 4, PH_ROUTE = 5, PH_UP = 6, PH_DOWN = 7, PH_FINAL = 8, PH_N = 9 };

__device__ __forceinline__ unsigned pk2(float lo, float hi) { return (unsigned)f2bf(lo) | ((unsigned)f2bf(hi) << 16); }
__device__ __forceinline__ void p0_transpose_item(const float* W, int K, int N, bf16_t* WT, int row_off, int blk, int blk_stride, LAS float* scr, int item, int lane, const float* ksc = nullptr) {
    const int nblk = N / 32, kb = item / nblk, nb = item % nblk, k0 = 64 * kb, n0 = 32 * nb;
#pragma unroll 8
    for (int i = 0; i < 32; ++i) { const int kk = 2 * i + (lane >> 5); float w = W[(size_t)(k0 + kk) * N + n0 + (lane & 31)]; if (ksc) w *= ksc[k0 + kk]; scr[kk * 33 + (lane & 31)] = w; }
    LDS_WAIT(); asm volatile("" ::: "memory");
    const int c = lane & 7; const int rbase = row_off + (n0 / blk) * blk_stride + (n0 % blk);
#pragma unroll
    for (int j = 0; j < 4; ++j) { const int n = (lane >> 3) + 8 * j; const LAS float* s = scr + (8 * c) * 33 + n;
        u32x4 o; o.x = pk2(s[0 * 33], s[1 * 33]); o.y = pk2(s[2 * 33], s[3 * 33]); o.z = pk2(s[4 * 33], s[5 * 33]); o.w = pk2(s[6 * 33], s[7 * 33]);
        *(u32x4*)(WT + (size_t)(rbase + n) * K + k0 + 8 * c) = o; }
    LDS_WAIT(); asm volatile("" ::: "memory");
}
__device__ __forceinline__ void rms_row_to_bf16(const float* xrow, const float* g, bf16_t* orow, int lane) {
    const f32x4* xr = (const f32x4*)xrow;
    f32x4 v[4]; float s = 0.f;
#pragma unroll
    for (int j = 0; j < 4; ++j) { v[j] = xr[lane + 64 * j]; s += (v[j].x * v[j].x + v[j].y * v[j].y) + (v[j].z * v[j].z + v[j].w * v[j].w); }
    const float rstd = rsqrtf(wave_sum(s) * (1.f / D) + EPS);
#pragma unroll
    for (int j = 0; j < 4; ++j) { const f32x4 gv = ((const f32x4*)g)[lane + 64 * j];
        uint2 o; o.x = cvt_pk_bf16(v[j].x * rstd * gv.x, v[j].y * rstd * gv.y); o.y = cvt_pk_bf16(v[j].z * rstd * gv.z, v[j].w * rstd * gv.w);
        ((uint2*)orow)[lane + 64 * j] = o; }
}

typedef float f32x2 __attribute__((ext_vector_type(2)));
struct EpiG1 {
    static constexpr bool PERM = true;
    bf16_t *U, *V, *Q, *Kb, *VV, *GA, *GB; float* vstat;
    __device__ __forceinline__ bool keep_acc(const pg8::Unit&) const { return false; }
    __device__ __forceinline__ void operator()(f32x4 (&acc)[2][2][4][2], const pg8::Unit& u, int wr, int wc, int fr, int fq) const {
        const int pn = u.pn, row0 = u.pm * 256 + wr * 64 + fr, cw = wc * 32 + 8 * fq;
        int act, ldc; bf16_t* d0; bf16_t* d1;
        if (pn < 2) { act = 1; ldc = 512; d0 = U + pn * 256 + cw; d1 = d0 + 128; }
        else if (pn < 4) { act = 2; ldc = 512; d0 = V + (pn - 2) * 256 + cw; d1 = d0 + 128; }
        else if (pn < 6) { act = 3; ldc = 512; d0 = Q + (pn - 4) * 256 + cw; d1 = d0 + 128; }
        else if (pn == 6) { act = 0; ldc = 128; d0 = Kb + cw; d1 = VV + cw; }
        else if (pn < 11) { act = 4; ldc = 1024; d0 = GA + (pn - 7) * 256 + cw; d1 = d0 + 128; }
        else { act = 4; ldc = 1024; d0 = GB + (pn - 11) * 256 + cw; d1 = d0 + 128; }
#pragma unroll
        for (int ai = 0; ai < 2; ++ai)
#pragma unroll
            for (int m = 0; m < 4; ++m) {
                const int row = row0 + ai * 128 + m * 16; float s = 0.f, q = 0.f;
#pragma unroll
                for (int bj = 0; bj < 2; ++bj) {
                    f32x4 v0 = acc[ai][bj][m][0], v1 = acc[ai][bj][m][1];
                    if (act == 1 || act == 2) {
#pragma unroll
                        for (int e = 0; e < 4; ++e) { v0[e] = fast_gelu(v0[e]); v1[e] = fast_gelu(v1[e]); }
                        if (act == 2) {
#pragma unroll
                            for (int e = 0; e < 4; ++e) { s += v0[e] + v1[e]; q += v0[e] * v0[e] + v1[e] * v1[e]; }
                        }
                    } else if (act == 3) { v0 = v0 * (0.125f * LOG2E); v1 = v1 * (0.125f * LOG2E); }
                    else if (act == 4) {
#pragma unroll
                        for (int e = 0; e < 4; ++e) { v0[e] = fast_sigmoid(v0[e]); v1[e] = fast_sigmoid(v1[e]); }
                    }
                    u32x4 w; w.x = cvt_pk_bf16(v0[0], v0[1]); w.y = cvt_pk_bf16(v0[2], v0[3]); w.z = cvt_pk_bf16(v1[0], v1[1]); w.w = cvt_pk_bf16(v1[2], v1[3]);
                    *(u32x4*)((bj ? d1 : d0) + (size_t)row * ldc) = w;
                }
                if (act == 2) {
                    s += __shfl_xor(s, 16); s += __shfl_xor(s, 32); q += __shfl_xor(q, 16); q += __shfl_xor(q, 32);
                    if (fq == 0) *(f32x2*)(vstat + (size_t)row * 16 + ((pn - 2) * 4 + wc) * 2) = (f32x2){s, q};
                }
            }
    }
};
struct SchedG1 {
    pg8::TileOrder o; const char* A; const char* B;
    __device__ __forceinline__ bool next(int i, pg8::Unit& u) const { int pm, pn; if (!o.tile(i, pm, pn)) return false;
        u.A = A + (size_t)pm * 256 * D * 2; u.B0 = B + (size_t)pn * 256 * D * 2; u.B1p = u.B0; u.pm = pm; u.pn = pn; u.aux = 0; u.slot = 0; return true; }
};
struct EpiG3 {
    static constexpr bool PERM = true;
    const bf16_t *GA, *GB; bf16_t* M;
    __device__ __forceinline__ bool keep_acc(const pg8::Unit& u) const { return u.aux == 0; }
    __device__ __forceinline__ void operator()(f32x4 (&acc)[2][2][4][2], const pg8::Unit& u, int wr, int wc, int fr, int fq) const {
        const int row0 = u.pm * 256 + wr * 64 + fr, col0 = u.pn * 256 + wc * 32 + 8 * fq;
#pragma unroll
        for (int ai = 0; ai < 2; ++ai)
#pragma unroll
            for (int m = 0; m < 4; ++m)
#pragma unroll
                for (int bj = 0; bj < 2; ++bj) {
                    const size_t off = (size_t)(row0 + ai * 128 + m * 16) * D + col0 + bj * 128;
                    const u32x4 gb = *(const u32x4*)(GB + off);
                    float b[8];
#pragma unroll
                    for (int e = 0; e < 4; ++e) { b[2 * e] = __uint_as_float(gb[e] << 16); b[2 * e + 1] = __uint_as_float(gb[e] & 0xffff0000u); }
                    if (u.aux == 0) {
                        const u32x4 ga = *(const u32x4*)(GA + off);
#pragma unroll
                        for (int e = 0; e < 4; ++e) { const float a0 = __uint_as_float(ga[e] << 16), a1 = __uint_as_float(ga[e] & 0xffff0000u);
                            const float r0 = a0 * __builtin_amdgcn_rcpf(fmaxf(b[2 * e], 1e-30f)), r1 = a1 * __builtin_amdgcn_rcpf(fmaxf(b[2 * e + 1], 1e-30f));
                            const int n = e >> 1, k = (e & 1) * 2; acc[ai][bj][m][n][k] *= r0; acc[ai][bj][m][n][k + 1] *= r1; }
                    } else {
                        const f32x4 v0 = acc[ai][bj][m][0], v1 = acc[ai][bj][m][1];
                        u32x4 w; w.x = cvt_pk_bf16(v0[0] * b[0], v0[1] * b[1]); w.y = cvt_pk_bf16(v0[2] * b[2], v0[3] * b[3]);
                        w.z = cvt_pk_bf16(v1[0] * b[4], v1[1] * b[5]); w.w = cvt_pk_bf16(v1[2] * b[6], v1[3] * b[7]);
                        *(u32x4*)(M + off) = w;
                    }
                }
    }
};
struct SchedG3 {
    pg8::TileOrder o; const char *A, *B, *WA, *WB;
    __device__ __forceinline__ bool next(int j, pg8::Unit& u) const { int pm, pn; if (!o.tile(j >> 1, pm, pn)) return false; const int w = j & 1;
        u.A = (w ? B : A) + (size_t)pm * 256 * 512 * 2; u.B0 = (w ? WB : WA) + (size_t)pn * 256 * 512 * 2; u.B1p = u.B0; u.pm = pm; u.pn = pn; u.aux = w; u.slot = 0; return true; }
};
struct EpiG4 {
    static constexpr bool PERM = true;
    const float* x; bf16_t* HB;
    __device__ __forceinline__ bool keep_acc(const pg8::Unit&) const { return false; }
    __device__ __forceinline__ void operator()(f32x4 (&acc)[2][2][4][2], const pg8::Unit& u, int wr, int wc, int fr, int fq) const {
        const int row0 = u.pm * 256 + wr * 64 + fr, col0 = u.pn * 256 + wc * 32 + 8 * fq;
#pragma unroll
        for (int ai = 0; ai < 2; ++ai)
#pragma unroll
            for (int m = 0; m < 4; ++m)
#pragma unroll
                for (int bj = 0; bj < 2; ++bj) { const size_t off = (size_t)(row0 + ai * 128 + m * 16) * D + col0 + bj * 128;
                    const f32x4 h0 = *(const f32x4*)(x + off) + acc[ai][bj][m][0], h1 = *(const f32x4*)(x + off + 4) + acc[ai][bj][m][1];
                    u32x4 w; w.x = cvt_pk_bf16(h0[0], h0[1]); w.y = cvt_pk_bf16(h0[2], h0[3]); w.z = cvt_pk_bf16(h1[0], h1[1]); w.w = cvt_pk_bf16(h1[2], h1[3]);
                    *(u32x4*)(HB + off) = w; }
    }
};
struct SchedG4 {
    pg8::TileOrder o; const char* A; const char* B;
    __device__ __forceinline__ bool next(int i, pg8::Unit& u) const { int pm, pn; if (!o.tile(i, pm, pn)) return false;
        u.A = A + (size_t)pm * 256 * D * 2; u.B0 = B + (size_t)pn * 256 * D * 2; u.B1p = u.B0; u.pm = pm; u.pn = pn; u.aux = 0; u.slot = 0; return true; }
};
__device__ __forceinline__ int class_of_tile(const LAS int* ctab, int mt) { int cls = 0;
#pragma unroll 1
    for (int c = 0; c < NCLS; ++c) if (mt * 256 >= ctab[c + 1]) cls = c + 1;
    return cls; }
struct SchedUp {
    const LAS int* ctab; const char* A; const char* W; int G, c;
    __device__ __forceinline__ bool next(int i, pg8::Unit& u) const { const int L = i * G + c, NU = (ctab[NCLS] >> 8) * 8; if (L >= NU) return false;
        const int mt = L >> 3, j = L & 7, cls = class_of_tile(ctab, mt); int e1, e2; class_experts(cls, e1, e2); const int e = j < 4 ? e1 : e2;
        u.A = A; u.B0 = W + ((size_t)e * 1024 + (j & 3) * 256) * D * 2; u.B1p = u.B0; u.pm = mt; u.pn = j; u.aux = cls; u.slot = i; return true; }
};
struct EpiUp {
    static constexpr bool PERM = true;
    const LAS int* ctab; const float* wl; bf16_t* HID;
    __device__ __forceinline__ bool keep_acc(const pg8::Unit&) const { return false; }
    __device__ __forceinline__ void operator()(f32x4 (&acc)[2][2][4][2], const pg8::Unit& u, int wr, int wc, int fr, int fq) const {
        const int cls = u.aux, sel = u.pn >> 2, rank0 = u.pm * 256 - ctab[cls], cnt = ctab[32 + cls];
        const int col0 = sel * 512 + (u.pn & 3) * 128 + wc * 32 + 8 * fq;
#pragma unroll
        for (int ai = 0; ai < 2; ++ai)
#pragma unroll
            for (int m = 0; m < 4; ++m) {
                const int R = ai * 128 + wr * 64 + m * 16 + fr, rank = rank0 + R;
                f32x4 wv = (f32x4){0.f, 0.f, 0.f, 0.f}; if (rank < cnt) wv = *(const f32x4*)(wl + ((size_t)cls * T + rank) * 4); const float w = sel ? wv[1] : wv[0], rs = wv[2];
                const f32x4 g0 = acc[ai][0][m][0], g1 = acc[ai][0][m][1], u0 = acc[ai][1][m][0], u1 = acc[ai][1][m][1];
                float h[8];
#pragma unroll
                for (int e = 0; e < 4; ++e) { const float ga = rs * g0[e], gb = rs * g1[e]; h[e] = (w * rs) * ga * fast_sigmoid(ga) * u0[e]; h[4 + e] = (w * rs) * gb * fast_sigmoid(gb) * u1[e]; }
                u32x4 o; o.x = cvt_pk_bf16(h[0], h[1]); o.y = cvt_pk_bf16(h[2], h[3]); o.z = cvt_pk_bf16(h[4], h[5]); o.w = cvt_pk_bf16(h[6], h[7]);
                *(u32x4*)(HID + ((size_t)u.pm * 256 + R) * 1024 + col0) = o;
            }
    }
};
struct SchedDown {
    const LAS int* ctab; const char* A; const char* W; int G, c;
    __device__ __forceinline__ bool next(int i, pg8::Unit& u) const { const int L = i * G + c, NU = (ctab[NCLS] >> 8) * 4; if (L >= NU) return false;
        const int mt = L >> 2, j = L & 3, cls = class_of_tile(ctab, mt); int e1, e2; class_experts(cls, e1, e2);
        u.A = A + (size_t)mt * 256 * 1024 * 2; u.B0 = W + ((size_t)e1 * 1024 + j * 256) * 512 * 2; u.B1p = W + ((size_t)e2 * 1024 + j * 256) * 512 * 2 - 8 * 128;
        u.pm = mt; u.pn = j; u.aux = cls; u.slot = i; return true; }
};
struct EpiDown {
    static constexpr bool PERM = true;
    const LAS int* idx; const bf16_t* HB; float* OUT;
    __device__ __forceinline__ bool keep_acc(const pg8::Unit&) const { return false; }
    __device__ __forceinline__ void operator()(f32x4 (&acc)[2][2][4][2], const pg8::Unit& u, int wr, int wc, int fr, int fq) const {
        const int col0 = u.pn * 256 + wc * 32 + 8 * fq;
#pragma unroll
        for (int ai = 0; ai < 2; ++ai)
#pragma unroll
            for (int m = 0; m < 4; ++m) {
                const int tok = idx[u.slot * 256 + ai * 128 + wr * 64 + m * 16 + fr];
                if (tok >= 0) {
#pragma unroll
                    for (int bj = 0; bj < 2; ++bj) { const size_t off = (size_t)tok * D + col0 + bj * 128;
                        const u32x4 hb = *(const u32x4*)(HB + off);
                        f32x4 o0 = acc[ai][bj][m][0], o1 = acc[ai][bj][m][1];
                        o0[0] += __uint_as_float(hb.x << 16); o0[1] += __uint_as_float(hb.x & 0xffff0000u); o0[2] += __uint_as_float(hb.y << 16); o0[3] += __uint_as_float(hb.y & 0xffff0000u);
                        o1[0] += __uint_as_float(hb.z << 16); o1[1] += __uint_as_float(hb.z & 0xffff0000u); o1[2] += __uint_as_float(hb.w << 16); o1[3] += __uint_as_float(hb.w & 0xffff0000u);
                        *(f32x4*)(OUT + off) = o0; *(f32x4*)(OUT + off + 4) = o1; }
                }
            }
    }
};
template <int NTN>
__device__ __forceinline__ void fill_idx(LAS int* idx, const LAS int* ctab, const int* list, int G, int c, const int tid) {
    const int NU = (ctab[NCLS] >> 8) * NTN;
    for (int i = 0; i < 8; ++i) { const int L = i * G + c; if (L >= NU) break;
        const int mt = L / NTN, cls = class_of_tile(ctab, mt);
        if (tid < 256) { const int rank = mt * 256 + tid - ctab[cls], cnt = ctab[32 + cls];
            idx[i * 256 + tid] = rank < cnt ? list[(size_t)cls * T + rank] : (list[(size_t)cls * T] | (int)0x80000000); } }
    __syncthreads();
}


typedef float f32x16 __attribute__((ext_vector_type(16)));
typedef short s16x4 __attribute__((ext_vector_type(4)));
typedef __bf16 bf16x2_t __attribute__((ext_vector_type(2)));
__device__ __forceinline__ unsigned cvtpk_c(float lo, float hi) { f32x2 v = {lo, hi}; bf16x2_t b = __builtin_convertvector(v, bf16x2_t); return __builtin_bit_cast(unsigned, b); }
__device__ __forceinline__ s16x4 lds_tr16(const LAS unsigned char* p) { return __builtin_bit_cast(s16x4, __builtin_amdgcn_ds_read_tr16_b64_v4i16((LAS s16x4*)p)); }
constexpr int VN_PITCH = 144;
__device__ __forceinline__ void gmlp_phase(LAS unsigned char* lds, const bf16_t* U, const bf16_t* V, const float* vstat, const float* gv, const bf16_t* wsb, const float* bs, bf16_t* A, int G, int bx, const int wave) {
    const int lane = lane_id_fresh(), tid = wave * 64 + lane, fr = lane & 15, fq = lane >> 4, q4 = fr >> 2, p4 = fr & 3;
    LAS unsigned char* VN = lds; LAS float* st = (LAS float*)(lds + 128 * VN_PITCH);
    for (int chunk = bx; chunk < T / 128; chunk += G) {
        __syncthreads();
        if (tid < 128) { const int row = chunk * 128 + tid; float s = 0.f, q = 0.f;
#pragma unroll
            for (int p = 0; p < 8; ++p) { const f32x2 v = *(const f32x2*)(vstat + (size_t)row * 16 + 2 * p); s += v.x; q += v.y; }
            const float mean = s * (1.f / 512.f), var = fmaxf(q * (1.f / 512.f) - mean * mean, 0.f); st[tid * 2] = mean; st[tid * 2 + 1] = rsqrtf(var + EPS); }
        for (int g = 0; g < 8; ++g) {
            __syncthreads();
            { const int s = tid >> 2, d0 = (tid & 3) * 16; const float mean = st[s * 2], rstd = st[s * 2 + 1];
              const bf16_t* src = V + (size_t)(chunk * 128 + s) * 512 + g * 64 + d0;
#pragma unroll
              for (int hh = 0; hh < 2; ++hh) { const u32x4 raw = *(const u32x4*)(src + 8 * hh); const f32x4 g0 = *(const f32x4*)(gv + g * 64 + d0 + 8 * hh), g1 = *(const f32x4*)(gv + g * 64 + d0 + 8 * hh + 4);
                  float f[8];
#pragma unroll
                  for (int e = 0; e < 4; ++e) { f[2 * e] = __uint_as_float(raw[e] << 16); f[2 * e + 1] = __uint_as_float(raw[e] & 0xffff0000u); }
                  u32x4 o; o.x = cvtpk_c((f[0] - mean) * rstd * g0[0], (f[1] - mean) * rstd * g0[1]); o.y = cvtpk_c((f[2] - mean) * rstd * g0[2], (f[3] - mean) * rstd * g0[3]);
                  o.z = cvtpk_c((f[4] - mean) * rstd * g1[0], (f[5] - mean) * rstd * g1[1]); o.w = cvtpk_c((f[6] - mean) * rstd * g1[2], (f[7] - mean) * rstd * g1[3]);
                  *(LAS u32x4*)(VN + s * VN_PITCH + (d0 + 8 * hh) * 2) = o; } }
            __syncthreads();
            f32x4 acc[4];
#pragma unroll
            for (int nb = 0; nb < 4; ++nb) acc[nb] = (f32x4){0.f, 0.f, 0.f, 0.f};
            const int nk = (wave >> 1) + 1;
            const bf16_t* wrow = wsb + (size_t)(g * 128 + 16 * wave + fr) * 128 + 8 * fq;
            for (int kk = 0; kk < nk; ++kk) {
                const bf16x8 a = *(const bf16x8*)(wrow + 32 * kk);
                const LAS unsigned char* vp = VN + (32 * kk + 8 * fq + q4) * VN_PITCH + 8 * p4;
#pragma unroll
                for (int nb = 0; nb < 4; ++nb) { const s16x4 lo = lds_tr16(vp + 32 * nb), hi = lds_tr16(vp + 4 * VN_PITCH + 32 * nb);
                    const bf16x8 b = __builtin_shufflevector(lo, hi, 0, 1, 2, 3, 4, 5, 6, 7);
                    acc[nb] = __builtin_amdgcn_mfma_f32_16x16x32_bf16(b, a, acc[nb], 0, 0, 0); }
            }
            { const int t = 16 * wave + fr; const float bias = bs[g * 128 + t]; const size_t o = (size_t)(chunk * 128 + t) * 512 + g * 64 + 4 * fq;
#pragma unroll
              for (int nb = 0; nb < 4; ++nb) { const uint2 uu = *(const uint2*)(U + o + 16 * nb);
                  const float u0 = __uint_as_float(uu.x << 16), u1 = __uint_as_float(uu.x & 0xffff0000u), u2 = __uint_as_float(uu.y << 16), u3 = __uint_as_float(uu.y & 0xffff0000u);
                  uint2 w; w.x = cvtpk_c(u0 * (acc[nb][0] + bias), u1 * (acc[nb][1] + bias)); w.y = cvtpk_c(u2 * (acc[nb][2] + bias), u3 * (acc[nb][3] + bias));
                  *(uint2*)(A + o + 16 * nb) = w; } }
        }
    }
}
constexpr int AK_PITCH = 144, AV_PITCH = 192, AT_K = 0, AT_V = 256 * AK_PITCH, AT_BIAS = AT_V + 256 * AV_PITCH, AT_LSC = AT_BIAS + 2048;
__device__ __forceinline__ void attn_phase(LAS unsigned char* lds, const bf16_t* Q, const bf16_t* Kb, const bf16_t* VV, const float* biasT, const float* sinks, bf16_t* B, int G, int bx, const int wave) {
    const int lane = lane_id_fresh(), tid = wave * 64 + lane, r32 = lane & 31, h2 = lane >> 5;
    const int q4 = (lane & 15) >> 2, p4 = lane & 3, blk2 = (lane >> 4) & 1;
    LAS unsigned char* Kl = lds + AT_K; LAS unsigned char* Vl = lds + AT_V; LAS float* biasL = (LAS float*)(lds + AT_BIAS); LAS float* lsc = (LAS float*)(lds + AT_LSC) + wave * 32;
    for (int unit = bx; unit < 512; unit += G) {
        const int kh = unit & 1, blk = unit >> 1, n = blk & 31, tok0 = blk * 128;
        __syncthreads();
#pragma unroll
        for (int it = 0; it < 4; ++it) { const int id = it * 512 + tid, row = id >> 3, ch = id & 7;
            u32x4 kv = (u32x4){0u, 0u, 0u, 0u}, vv = (u32x4){0u, 0u, 0u, 0u};
            if (n > 0 || row >= 128) { const size_t src = (size_t)(tok0 - 128 + row) * 128 + kh * 64 + ch * 8; kv = *(const u32x4*)(Kb + src); vv = *(const u32x4*)(VV + src); }
            *(LAS u32x4*)(Kl + row * AK_PITCH + ch * 16) = kv; *(LAS u32x4*)(Vl + row * AV_PITCH + ch * 16) = vv; }
        biasL[tid] = biasT[kh * 512 + tid];
        __syncthreads();
        const int hq = wave >> 1, head = kh * 4 + hq;
        const float sink2 = sinks[head] * LOG2E;
#pragma unroll 1
        for (int qq = 0; qq < 2; ++qq) {
            const int qs = (wave & 1) * 2 + qq;
            bf16x8 qf[4]; { const bf16_t* qp = Q + (size_t)(tok0 + 32 * qs + r32) * 512 + head * 64 + 8 * h2;
#pragma unroll
                for (int ks = 0; ks < 4; ++ks) qf[ks] = *(const bf16x8*)(qp + 16 * ks); }
            f32x16 S[5];
#pragma unroll
            for (int kt = 0; kt < 5; ++kt) {
#pragma unroll
                for (int r = 0; r < 16; ++r) S[kt][r] = 0.f;
                const LAS unsigned char* kp = Kl + (32 * (qs + kt) + r32) * AK_PITCH + 16 * h2;
#pragma unroll
                for (int ks = 0; ks < 4; ++ks) { const bf16x8 kf = *(const LAS bf16x8*)(kp + 32 * ks); S[kt] = __builtin_amdgcn_mfma_f32_32x32x16_bf16(kf, qf[ks], S[kt], 0, 0, 0); }
            }
            float m = sink2;
#pragma unroll
            for (int kt = 0; kt < 5; ++kt) {
                const bool tile_ok = (n > 0) || (qs + kt >= 4);
#pragma unroll
                for (int r = 0; r < 16; ++r) { const int cr = (r & 3) + 8 * (r >> 2) + 4 * h2; const int dist = 128 - 32 * kt + r32 - cr;
                    bool valid = tile_ok; if (kt == 0) valid = valid && (dist < 128); if (kt == 4) valid = valid && (dist >= 0);
                    const float s = valid ? S[kt][r] + biasL[hq * 128 + (dist & 127)] : -1e30f;
                    S[kt][r] = s; m = fmaxf(m, s); }
            }
            m = fmaxf(m, __shfl_xor(m, 32));
            float l = 0.f;
#pragma unroll
            for (int kt = 0; kt < 5; ++kt)
#pragma unroll
                for (int r = 0; r < 16; ++r) { const float p = __builtin_amdgcn_exp2f(S[kt][r] - m); S[kt][r] = p; l += p; }
            l += __shfl_xor(l, 32); l += __builtin_amdgcn_exp2f(sink2 - m);
            if (h2 == 0) lsc[r32] = 1.f / l;
            f32x16 O[2];
#pragma unroll
            for (int r = 0; r < 16; ++r) { O[0][r] = 0.f; O[1][r] = 0.f; }
#pragma unroll
            for (int kt = 0; kt < 5; ++kt)
#pragma unroll
                for (int s2 = 0; s2 < 2; ++s2) {
                    u32x4 pw; pw.x = cvtpk_c(S[kt][8 * s2 + 0], S[kt][8 * s2 + 1]); pw.y = cvtpk_c(S[kt][8 * s2 + 2], S[kt][8 * s2 + 3]);
                    pw.z = cvtpk_c(S[kt][8 * s2 + 4], S[kt][8 * s2 + 5]); pw.w = cvtpk_c(S[kt][8 * s2 + 6], S[kt][8 * s2 + 7]);
                    const bf16x8 pa = __builtin_bit_cast(bf16x8, pw);
                    const LAS unsigned char* vp = Vl + (32 * (qs + kt) + 16 * s2 + 4 * h2 + q4) * AV_PITCH + (16 * blk2 + 4 * p4) * 2;
#pragma unroll
                    for (int db = 0; db < 2; ++db) { const s16x4 lo = lds_tr16(vp + 64 * db), hi = lds_tr16(vp + 8 * AV_PITCH + 64 * db);
                        const bf16x8 vb = __builtin_shufflevector(lo, hi, 0, 1, 2, 3, 4, 5, 6, 7);
                        O[db] = __builtin_amdgcn_mfma_f32_32x32x16_bf16(pa, vb, O[db], 0, 0, 0); }
                }
#pragma unroll
            for (int r = 0; r < 16; ++r) { const int cr = (r & 3) + 8 * (r >> 2) + 4 * h2; const float rl = lsc[cr];
                bf16_t* op = B + (size_t)(tok0 + 32 * qs + cr) * 512 + head * 64 + r32;
                op[0] = f2bf(O[0][r] * rl); op[32] = f2bf(O[1][r] * rl); }
        }
    }
}


__device__ __forceinline__ void router_phase(LAS unsigned char* lds, const bf16_t* HB, const float* g2, const float* rgw, const float* rgb, const float* rew, const float* reb,
                                             unsigned* ctl, int* LIST, float* WL4, int G, int bx, const int wave) {
    const int lane = lane_id_fresh(), tid = wave * 64 + lane, col = lane & 15, kq = lane >> 4;
    LAS float* WLds = (LAS float*)(lds + RING_OFF);
    LAS float* LG = (LAS float*)(lds + LG_OFF) + wave * 512;
    LAS int* rcls = (LAS int*)(lds + RSC_OFF); LAS float* rwa = (LAS float*)(lds + RSC_OFF + 512); LAS float* rwb = (LAS float*)(lds + RSC_OFF + 1024); LAS float* rrs = (LAS float*)(lds + RSC_OFF + 1536);
    LAS int* rbase = (LAS int*)(lds + LG_OFF);
    __syncthreads();
    for (int id = tid; id < 32768; id += 512) { const int k = id >> 5, c = id & 31; float w = 0.f;
        if (c < 4) w = rgw[k * 4 + c]; else if (c < 20) w = rew[((size_t)((c - 4) >> 2) * D + k) * 4 + ((c - 4) & 3)];
        w *= g2[k];
        WLds[((((((k >> 5) * 2 + (c >> 4)) * 2 + ((k & 7) >> 2)) * 4 + ((k >> 3) & 3)) * 16 + (c & 15)) * 4 + (k & 3))] = w; }
    __syncthreads();
    for (int chunk = bx; chunk < T / 128; chunk += G) {
        const int tl = wave * 16 + col, token = chunk * 128 + tl;
        const bf16_t* hp = HB + (size_t)token * D + 8 * kq;
        f32x4 acc0 = (f32x4){0.f, 0.f, 0.f, 0.f}, acc1 = acc0; float ss = 0.f;
        const LAS float* wp0 = WLds + (kq * 16 + col) * 4;
#pragma unroll 1
        for (int i0 = 0; i0 < 32; i0 += 4) {
            f32x4 v[4][2];
#pragma unroll
            for (int u = 0; u < 4; ++u) { const u32x4 raw = *(const u32x4*)(hp + 32 * (i0 + u));
                v[u][0] = (f32x4){__uint_as_float(raw.x << 16), __uint_as_float(raw.x & 0xffff0000u), __uint_as_float(raw.y << 16), __uint_as_float(raw.y & 0xffff0000u)};
                v[u][1] = (f32x4){__uint_as_float(raw.z << 16), __uint_as_float(raw.z & 0xffff0000u), __uint_as_float(raw.w << 16), __uint_as_float(raw.w & 0xffff0000u)}; }
#pragma unroll
            for (int u = 0; u < 4; ++u) {
                const LAS float* wp = wp0 + (i0 + u) * 1024;
#pragma unroll
                for (int eh = 0; eh < 2; ++eh) { const f32x4 a = v[u][eh]; ss += (a[0] * a[0] + a[1] * a[1]) + (a[2] * a[2] + a[3] * a[3]);
                    const f32x4 b0 = *(const LAS f32x4*)(wp + eh * 256), b1 = *(const LAS f32x4*)(wp + 512 + eh * 256);
#pragma unroll
                    for (int e = 0; e < 4; ++e) { acc0 = __builtin_amdgcn_mfma_f32_16x16x4f32(a[e], b0[e], acc0, 0, 0, 0); acc1 = __builtin_amdgcn_mfma_f32_16x16x4f32(a[e], b1[e], acc1, 0, 0, 0); } }
            }
        }
        ss += __shfl_xor(ss, 16); ss += __shfl_xor(ss, 32);
        const float rstd = rsqrtf(ss * (1.f / D) + EPS);
#pragma unroll
        for (int r = 0; r < 4; ++r) { LG[(4 * kq + r) * 32 + col] = acc0[r]; LG[(4 * kq + r) * 32 + 16 + col] = acc1[r]; }
        if (lane < 16) { float lg[20];
#pragma unroll
            for (int o = 0; o < 20; ++o) lg[o] = LG[lane * 32 + o] * rstd;
            int cls; float wa, wb; route_token(lg, rgb, reb, cls, wa, wb); rcls[tl] = cls; rwa[tl] = wa; rwb[tl] = wb; rrs[tl] = rstd; }
        __syncthreads();
        if (tid < NCLS) { int n = 0; for (int i = 0; i < 128; ++i) n += (rcls[i] == tid) ? 1 : 0; rbase[tid] = n ? (int)atomicAdd(ctl + CW_CNT + 16 * tid, (unsigned)n) : 0; }
        __syncthreads();
        if (tid < 128) { const int cls = rcls[tid]; int lr = 0; for (int i = 0; i < tid; ++i) lr += (rcls[i] == cls) ? 1 : 0; const int rank = rbase[cls] + lr;
            LIST[(size_t)cls * T + rank] = chunk * 128 + tid; *(f32x4*)(WL4 + ((size_t)cls * T + rank) * 4) = (f32x4){rwa[tid], rwb[tid], rrs[tid], 0.f}; }
        __syncthreads();
    }
}

__global__ void __launch_bounds__(512, 2) mk_fwd(MkArgs args) {
    extern __shared__ __attribute__((aligned(16))) unsigned char lds_raw[];
    LAS unsigned char* lds = (LAS unsigned char*)lds_raw;
    volatile LAS unsigned* MISC = (volatile LAS unsigned*)(lds + LDSCTL_OFF);
    LAS int* ctab = (LAS int*)(lds + CTAB_OFF);
    LAS int* idx = (LAS int*)(lds + IDX_OFF);
    const int wave = __builtin_amdgcn_readfirstlane((int)threadIdx.x >> 6);
#define lane lane_id_fresh()
#define tid (wave * 64 + lane_id_fresh())
    const int G = gridDim.x, bx = blockIdx.x; const int vcu = (G % 8 == 0) ? (bx % 8) * (G / 8) + bx / 8 : bx;
    unsigned char* ws = args.ws;
    unsigned* ctl = (unsigned*)(ws + WS_CTL);
    const float* x = args.in[0];
    bf16_t* WIN = (bf16_t*)(ws + WS_WIN); bf16_t* WPA = (bf16_t*)(ws + WS_WPA); bf16_t* WPB = (bf16_t*)(ws + WS_WPB); bf16_t* WOUT = (bf16_t*)(ws + WS_WOUT);
    bf16_t* WUP = (bf16_t*)(ws + WS_WUP); bf16_t* WDN = (bf16_t*)(ws + WS_WDN); bf16_t* WSB = (bf16_t*)(ws + WS_WSB); float* BIAS = (float*)(ws + WS_BIAS);
    bf16_t* HN = (bf16_t*)(ws + WS_HN); bf16_t* U = (bf16_t*)(ws + WS_U); bf16_t* V = (bf16_t*)(ws + WS_V); bf16_t* Q = (bf16_t*)(ws + WS_Q); bf16_t* Kb = (bf16_t*)(ws + WS_K);
    bf16_t* VV = (bf16_t*)(ws + WS_VV); bf16_t* GA = (bf16_t*)(ws + WS_GA); bf16_t* GB = (bf16_t*)(ws + WS_GB); bf16_t* A = (bf16_t*)(ws + WS_A); bf16_t* B = (bf16_t*)(ws + WS_B);
    float* H = (float*)(ws + WS_H); bf16_t* HID = (bf16_t*)(ws + WS_HID); float* VSTAT = (float*)(ws + WS_VSTAT); int* LIST = (int*)(ws + WS_LIST); float* WL = (float*)(ws + WS_WL);
    bf16_t* MERGED = HN; bf16_t* HG = (bf16_t*)(ws + WS_HG); float* WL4 = (float*)(ws + WS_WL4);

    for (int u = tid; u < 128; u += 512) MISC[u] = 0u;
    __syncthreads();
    XcdBarrier bar = xcd_barrier_post(ctl + CW_BAR + args.li * XCD_BAR_WORDS, MISC + 8);
    const int lo = args.ph_lo, hi = args.ph_hi;
#define IN(k) (lo <= (k) && (k) < hi)
#define SEAM(k) do { if (IN(k) && IN((k) + 1)) xcd_barrier(bar); } while (0)

    if (IN(PH_PRO)) {
        LAS float* scr = (LAS float*)(lds + RING_OFF + wave * 16384);
        const int gw = vcu * 8 + wave, NGW = G * 8;
        constexpr int I_IN = (D / 64) * (NIN / 32), I_P = (512 / 64) * (D / 32), I_O = (D / 64) * (D / 32), I_G = (D / 64) * (FF / 32), I_D = (FF / 64) * (D / 32);
        constexpr int NITEMS = I_IN + 2 * I_P + I_O + NEXP * (2 * I_G + I_D);
        for (int it = gw; it < NITEMS; it += NGW) {
            int r = it;
            if (r < I_IN) { p0_transpose_item(args.in[2], D, NIN, WIN, 0, NIN, NIN, scr, r, lane); continue; } r -= I_IN;
            if (r < I_P) { p0_transpose_item(args.in[8], 512, D, WPA, 0, D, D, scr, r, lane); continue; } r -= I_P;
            if (r < I_P) { p0_transpose_item(args.in[9], 512, D, WPB, 0, D, D, scr, r, lane); continue; } r -= I_P;
            if (r < I_O) { p0_transpose_item(args.in[10], D, D, WOUT, 0, D, D, scr, r, lane); continue; } r -= I_O;
            const int e = r / (2 * I_G + I_D); r -= e * (2 * I_G + I_D);
            if (r < I_G) { p0_transpose_item(args.in[16] + (size_t)e * D * FF, D, FF, WUP + (size_t)e * 1024 * D, 0, 128, 256, scr, r, lane, args.in[11]); continue; } r -= I_G;
            if (r < I_G) { p0_transpose_item(args.in[17] + (size_t)e * D * FF, D, FF, WUP + (size_t)e * 1024 * D, 128, 128, 256, scr, r, lane, args.in[11]); continue; } r -= I_G;
            p0_transpose_item(args.in[18] + (size_t)e * FF * D, FF, D, WDN + (size_t)e * 1024 * FF, 0, D, D, scr, r, lane);
        }
        for (int i = (vcu * 512 + tid); i < 8 * 128 * 128; i += G * 512) { const int s = i & 127, t = (i >> 7) & 127; WSB[i] = (s <= t) ? f2bf(args.in[4][i]) : (bf16_t)0; }
        for (int i = (vcu * 512 + tid); i < 8 * 128; i += G * 512) { const int h = i >> 7, dist = i & 127; BIAS[i] = args.in[7][kBucket[dist] * 8 + h] * LOG2E; }
        for (int m = gw; m < T; m += NGW) rms_row_to_bf16(x + (size_t)m * D, args.in[1], HN + (size_t)m * D, lane);
    }
    SEAM(PH_PRO);
    if (IN(PH_G1)) {
        SchedG1 S; S.o.init(T, NIN, G, bx); S.A = (const char*)HN; S.B = (const char*)WIN;
        EpiG1 E{U, V, Q, Kb, VV, GA, GB, VSTAT};
        pg8::gemm_phase<EpiG1, SchedG1, false>(lds + RING_OFF, D, D, S, E, idx, wave);
    }
    SEAM(PH_G1);
    if (IN(PH_MIX)) {
        gmlp_phase(lds + RING_OFF, U, V, VSTAT, args.in[3], WSB, args.in[5], A, G, bx, wave);
        attn_phase(lds + RING_OFF, Q, Kb, VV, BIAS, args.in[6], B, G, bx, wave);
    }
    SEAM(PH_MIX);
    if (IN(PH_G3)) {
        SchedG3 S; S.o.init(T, D, G, bx); S.A = (const char*)A; S.B = (const char*)B; S.WA = (const char*)WPA; S.WB = (const char*)WPB;
        EpiG3 E{GA, GB, MERGED};
        pg8::gemm_phase<EpiG3, SchedG3, false>(lds + RING_OFF, 512, 512, S, E, idx, wave);
    }
    SEAM(PH_G3);
    if (IN(PH_G4)) {
        SchedG4 S; S.o.init(T, D, G, bx); S.A = (const char*)MERGED; S.B = (const char*)WOUT;
        EpiG4 E{x, HG};
        pg8::gemm_phase<EpiG4, SchedG4, false>(lds + RING_OFF, D, D, S, E, idx, wave);
    }
    SEAM(PH_G4);
    if (IN(PH_ROUTE)) router_phase(lds, HG, args.in[11], args.in[12], args.in[13], args.in[14], args.in[15], ctl, LIST, WL4, G, bx, wave);
    SEAM(PH_ROUTE);
    if (IN(PH_UP) || IN(PH_DOWN)) {
        if (tid == 0) { int off = 0; for (int c = 0; c < NCLS; ++c) { const int n = (int)ctl[CW_CNT + 16 * c]; ctab[c] = off; ctab[32 + c] = n; off += (n + 255) & ~255; } ctab[NCLS] = off; }
        __syncthreads();
    }
    if (IN(PH_UP)) {
        fill_idx<8>(idx, ctab, LIST, G, bx, wave * 64 + lane_id_fresh());
        SchedUp S{ctab, (const char*)HG, (const char*)WUP, G, bx};
        EpiUp E{ctab, WL4, HID};
        pg8::gemm_phase<EpiUp, SchedUp, true>(lds + RING_OFF, D, D, S, E, idx, wave);
    }
    SEAM(PH_UP);
    if (IN(PH_DOWN)) {
        fill_idx<4>(idx, ctab, LIST, G, bx, wave * 64 + lane_id_fresh());
        SchedDown S{ctab, (const char*)HID, (const char*)WDN, G, bx};
        EpiDown E{idx, HG, args.out};
        pg8::gemm_phase<EpiDown, SchedDown, false>(lds + RING_OFF, D, 512, S, E, idx, wave);
    }
    SEAM(PH_DOWN);
    if (IN(PH_FINAL)) {
        const int gw = vcu * 8 + wave, NGW = G * 8;
        for (int m = gw; m < T; m += NGW) { f32x4* xr = (f32x4*)(args.out + (size_t)m * D); f32x4 v[4]; float s = 0.f;
#pragma unroll
            for (int j = 0; j < 4; ++j) { v[j] = xr[lane + 64 * j]; s += (v[j].x * v[j].x + v[j].y * v[j].y) + (v[j].z * v[j].z + v[j].w * v[j].w); }
            const float rstd = rsqrtf(wave_sum(s) * (1.f / D) + EPS);
#pragma unroll
            for (int j = 0; j < 4; ++j) { const f32x4 gv = ((const f32x4*)args.in[19])[lane + 64 * j]; xr[lane + 64 * j] = v[j] * rstd * gv; } }
    }
#undef IN
#undef SEAM
#undef lane
#undef tid
}
static int mk_grid() {
    static int grid = 0;
    if (grid == 0) {
        int dev = 0, cus = 0, per_cu = 0;
        if (hipGetDevice(&dev) != hipSuccess || hipDeviceGetAttribute(&cus, hipDeviceAttributeMultiprocessorCount, dev) != hipSuccess) { grid = -1; return grid; }
        if (hipFuncSetAttribute((const void*)mk_fwd, hipFuncAttributeMaxDynamicSharedMemorySize, LDS_BYTES) != hipSuccess) { fprintf(stderr, "kernel_launch: hipFuncSetAttribute failed\n"); grid = -1; return grid; }
        if (hipOccupancyMaxActiveBlocksPerMultiprocessor(&per_cu, (const void*)mk_fwd, 512, LDS_BYTES) != hipSuccess || per_cu < 1) { fprintf(stderr, "kernel_launch: occupancy query says %d\n", per_cu); }
        (void)hipGetLastError();
        grid = cus;
    }
    return grid;
}
extern "C" void kernel_launch(void* const* d_in, const int* in_sizes, int n_in, void* d_out, int out_size, void* d_ws, size_t ws_size, hipStream_t stream) {
    if (n_in != 20 || out_size != T * D || ws_size < WS_END) { fprintf(stderr, "kernel_launch: unexpected shapes (n_in %d out %d ws %zu)\n", n_in, out_size, ws_size); return; }
    const int grid = mk_grid(); if (grid <= 0) return;
    unsigned char* ws = (unsigned char*)d_ws;
    (void)hipMemsetAsync(ws + WS_CTL, 0, CTL_BYTES, stream);
    MkArgs a{}; for (int i = 0; i < 20; ++i) a.in[i] = (const float*)d_in[i]; a.out = (float*)d_out; a.ws = ws;
    a.ph_lo = PH_PRO; a.ph_hi = PH_N; a.li = 0; hipLaunchKernelGGL(mk_fwd, dim3(grid), dim3(512), LDS_BYTES, stream, a);
}
```
